# Optimizing an MI355X kernel written in HIP

```python
import jax, jax.numpy as jnp
from jax import lax
import numpy as np

D_MODEL = 4096
BATCH = 4
SEQ = 4096
DEPTH = 2
DEC_BATCH = 16
DEC_SEQ = 32
PAST_LEN = 2048

CHUNK = 64
MIX_DIM = D_MODEL
RWKV_HEAD = 64
RWKV_DIM = D_MODEL // 4
RWKV_HEADS = RWKV_DIM // RWKV_HEAD
RWKV_LORA = 64
RWKV_SHIFT_DIM = 3 * RWKV_DIM + 2 * RWKV_LORA
RWKV_GN_EPS = 64e-5
MLA_HEADS = 16
MLA_NOPE = 128
MLA_ROPE = 64
MLA_VHEAD = 128
MLA_DIM = MLA_HEADS * MLA_VHEAD
Q_LORA = D_MODEL // 4
KV_LORA = 512
ROPE_BASE = 10000.0
Q_BLOCK = 128
CONV_DIM = MIX_DIM - RWKV_DIM - MLA_DIM
CONV_W = 3
NORM_EPS = 1e-6
IN_COLS = (RWKV_SHIFT_DIM + RWKV_DIM + Q_LORA + KV_LORA + MLA_ROPE + MLA_DIM
           + 4 * CONV_DIM)

kernel_name = "hybrid_rwkv7_mla_shortconv_stream_step"


def rms_norm(x, g, eps=NORM_EPS):
    xf = x.astype(jnp.float32)
    y = xf * lax.rsqrt(jnp.mean(xf * xf, axis=-1, keepdims=True) + eps)
    return (y * g.astype(jnp.float32)).astype(x.dtype)


def rotary(x, pos):
    half = MLA_ROPE // 2
    freqs = ROPE_BASE ** (-jnp.arange(half, dtype=jnp.float32) / half)
    ang = pos.astype(jnp.float32)[:, None] * freqs[None, :]
    ang = ang.reshape((ang.shape[0],) + (1,) * (x.ndim - 3) + (half,))
    cos, sin = jnp.cos(ang), jnp.sin(ang)
    xf = x.astype(jnp.float32)
    x1, x2 = xf[..., :half], xf[..., half:]
    return jnp.concatenate([x1 * cos - x2 * sin, x2 * cos + x1 * sin], axis=-1).astype(x.dtype)


def split_columns(p):
    sizes = (RWKV_SHIFT_DIM, RWKV_DIM, Q_LORA, KV_LORA, MLA_ROPE, MLA_DIM,
             CONV_DIM, CONV_DIM, CONV_DIM, CONV_DIM)
    out, start = [], 0
    for s in sizes:
        out.append(p[..., start:start + s])
        start += s
    return out


def block_causal_attention(q_nope, q_rope, k_nope, k_rope, v, q_pos, k_pos):
    scale = (MLA_NOPE + MLA_ROPE) ** -0.5
    k_chunk = k_pos // CHUNK
    q_chunk = q_pos // CHUNK

    def one_block(args):
        qn, qr, qc = args
        s = (jnp.einsum('bqhd,bkhd->bhqk', qn, k_nope).astype(jnp.float32)
             + jnp.einsum('bqhd,bkd->bhqk', qr, k_rope).astype(jnp.float32)) * scale
        visible = k_chunk[None, :] <= qc[:, None]
        s = jnp.where(visible[None, None], s, -1e30)
        p = jax.nn.softmax(s, axis=-1)
        return jnp.einsum('bhqk,bkhd->bqhd', p.astype(v.dtype), v)

    B, T = q_nope.shape[:2]
    if T > Q_BLOCK and T % Q_BLOCK == 0:
        nb = T // Q_BLOCK

        def blocks(t):
            return jnp.moveaxis(t.reshape((B, nb, Q_BLOCK) + t.shape[2:]), 1, 0)

        out = lax.map(one_block, (blocks(q_nope), blocks(q_rope), q_chunk.reshape(nb, Q_BLOCK)))
        return jnp.moveaxis(out, 0, 1).reshape((B, T) + out.shape[3:])
    return one_block((q_nope, q_rope, q_chunk))


def rwkv7_scan(S0, r, w, k, v, kk, a):
    def step(S, inp):
        r_t, w_t, k_t, v_t, kk_t, a_t = inp
        sa = jnp.einsum('bhvk,bhk->bhv', S, -kk_t)
        S = (S * w_t[:, :, None, :] + sa[..., :, None] * (kk_t * a_t)[..., None, :]
             + v_t[..., :, None] * k_t[..., None, :])
        o = jnp.einsum('bhvk,bhk->bhv', S, r_t)
        return S, o

    xs = tuple(jnp.moveaxis(t, 1, 0) for t in (r, w, k, v, kk, a))
    S, o = lax.scan(step, S0, xs)
    return S, jnp.moveaxis(o, 0, 1)


def mixer_layer(x, c, rw_state, rw_shift, conv_buf, lat_past, kr_past,
                w_ada, b_ada, norm_g, w_in, rw_mu, rw_w0, rw_w2, rw_a0, rw_a2,
                rw_kk, rw_ka, rw_rk, rw_ln_g, rw_ln_b, mla_qnorm_g, mla_kvnorm_g,
                mla_w_uq, mla_w_uk, mla_w_uv, mla_qn_nope, mla_qn_rope,
                mla_kn_nope, mla_kn_rope, conv_w, conv_b, w_out):
    B, T, _ = x.shape
    P = lat_past.shape[1]
    f32 = jnp.float32
    q_pos = jnp.arange(P, P + T, dtype=jnp.int32)
    k_pos = jnp.arange(P + T, dtype=jnp.int32)

    mod = c @ w_ada + b_ada
    shift, scale, gate = jnp.split(mod, 3, axis=-1)
    h = rms_norm(x, norm_g) * (1 + scale[:, None]) + shift[:, None]
    proj = h @ w_in
    (rw_pre, rw_gate, cq, ckv, kr_raw, mla_gate,
     cv_b, cv_c, cv_x, cv_gate) = split_columns(proj)

    prev = jnp.concatenate([rw_shift[:, None].astype(rw_pre.dtype), rw_pre[:, :-1]], axis=1)
    xs = rw_pre + (prev - rw_pre) * rw_mu
    r = xs[..., :RWKV_DIM]
    k = xs[..., RWKV_DIM:2 * RWKV_DIM]
    v = xs[..., 2 * RWKV_DIM:3 * RWKV_DIM]
    wl = xs[..., 3 * RWKV_DIM:3 * RWKV_DIM + RWKV_LORA]
    al = xs[..., 3 * RWKV_DIM + RWKV_LORA:]
    w_log = -jax.nn.softplus(-(rw_w0 + jnp.tanh(wl) @ rw_w2).astype(f32)) - 0.5
    decay = jnp.exp(-jnp.exp(w_log))
    a = jax.nn.sigmoid((rw_a0 + al @ rw_a2).astype(f32))

    def heads(t):
        return t.astype(f32).reshape(B, T, RWKV_HEADS, RWKV_HEAD)

    kk = heads(k.astype(f32) * rw_kk.astype(f32))
    kk = kk * lax.rsqrt(jnp.sum(kk * kk, axis=-1, keepdims=True) + 1e-12)
    k_mod = k.astype(f32) * (1 + (a - 1) * rw_ka.astype(f32))
    rh, kh, vh, ah, dh = heads(r), heads(k_mod), heads(v), heads(a), heads(decay)
    new_rw_state, o = rwkv7_scan(rw_state.astype(f32), rh, dh, kh, vh, kk, ah)
    mu = jnp.mean(o, axis=-1, keepdims=True)
    var = jnp.mean(jnp.square(o - mu), axis=-1, keepdims=True)
    o = ((o - mu) * lax.rsqrt(var + RWKV_GN_EPS)).reshape(B, T, RWKV_DIM)
    o = o * rw_ln_g.astype(f32) + rw_ln_b.astype(f32)
    bonus = jnp.sum(rh * kh * rw_rk.astype(f32), axis=-1, keepdims=True) * vh
    rw_out = (o + bonus.reshape(B, T, RWKV_DIM)).astype(x.dtype) * jax.nn.silu(rw_gate)

    q = (rms_norm(cq, mla_qnorm_g) @ mla_w_uq).reshape(B, T, MLA_HEADS, MLA_NOPE + MLA_ROPE)
    q_nope = rms_norm(q[..., :MLA_NOPE], mla_qn_nope)
    q_rope = rotary(rms_norm(q[..., MLA_NOPE:], mla_qn_rope), q_pos)
    lat_new = rms_norm(ckv, mla_kvnorm_g)
    kr_new = rotary(rms_norm(kr_raw, mla_kn_rope), q_pos)
    lat_all = jnp.concatenate([lat_past.astype(lat_new.dtype), lat_new], axis=1)
    kr_all = jnp.concatenate([kr_past.astype(kr_new.dtype), kr_new], axis=1)
    k_nope = rms_norm((lat_all @ mla_w_uk).reshape(B, P + T, MLA_HEADS, MLA_NOPE), mla_kn_nope)
    v_mla = (lat_all @ mla_w_uv).reshape(B, P + T, MLA_HEADS, MLA_VHEAD)
    attn = block_causal_attention(q_nope, q_rope, k_nope, kr_all, v_mla, q_pos, k_pos)
    mla_out = attn.reshape(B, T, MLA_DIM) * jax.nn.silu(mla_gate)

    u = cv_c * cv_x
    up = jnp.concatenate([conv_buf.astype(u.dtype), u], axis=1)
    y = conv_b + up[:, 0:T] * conv_w[0]
    for j in range(1, CONV_W):
        y = y + up[:, j:j + T] * conv_w[j]
    cv_out = cv_b * y * jax.nn.silu(cv_gate)
    new_conv = up[:, T:]

    mix = jnp.concatenate([rw_out, mla_out, cv_out], axis=-1) @ w_out
    x_out = x + gate[:, None] * mix
    return x_out, lat_new, kr_new, new_rw_state.astype(x.dtype), rw_pre[:, -1], new_conv


def setup_inputs(seed: int = 0) -> dict:
    key = jax.random.key(seed)
    ks = iter(jax.random.split(key, 48))

    def nrm(shape, s):
        return s * jax.random.normal(next(ks), shape, jnp.float32)

    D = D_MODEL
    return {
        "x_prompt": nrm((BATCH, SEQ, D), 1.0),
        "x_sample": nrm((DEC_BATCH, DEC_SEQ, D), 1.0),
        "c_prompt": nrm((BATCH, D), 1.0),
        "c_sample": nrm((DEC_BATCH, D), 1.0),
        "cache_mla_latent": nrm((DEPTH, DEC_BATCH, PAST_LEN, KV_LORA), 1.0),
        "cache_mla_krope": nrm((DEPTH, DEC_BATCH, PAST_LEN, MLA_ROPE), 1.0),
        "state_rwkv": nrm((DEPTH, DEC_BATCH, RWKV_HEADS, RWKV_HEAD, RWKV_HEAD), 0.3),
        "state_rwkv_shift": nrm((DEPTH, DEC_BATCH, RWKV_SHIFT_DIM), 1.0),
        "state_conv": nrm((DEPTH, DEC_BATCH, CONV_W - 1, CONV_DIM), 1.0),
        "w_ada": nrm((DEPTH, D, 3 * D), 0.3 * D ** -0.5),
        "b_ada": nrm((DEPTH, 3 * D), 0.02),
        "norm_g": 1.0 + nrm((DEPTH, D), 0.02),
        "w_in": nrm((DEPTH, D, IN_COLS), D ** -0.5),
        "rw_mu": jax.random.uniform(next(ks), (DEPTH, RWKV_SHIFT_DIM), jnp.float32),
        "rw_w0": nrm((DEPTH, RWKV_DIM), 0.5),
        "rw_w2": nrm((DEPTH, RWKV_LORA, RWKV_DIM), 0.5 * RWKV_LORA ** -0.5),
        "rw_a0": nrm((DEPTH, RWKV_DIM), 0.5),
        "rw_a2": nrm((DEPTH, RWKV_LORA, RWKV_DIM), 0.5 * RWKV_LORA ** -0.5),
        "rw_kk": 0.85 + nrm((DEPTH, RWKV_DIM), 0.02),
        "rw_ka": 1.0 + nrm((DEPTH, RWKV_DIM), 0.02),
        "rw_rk": nrm((DEPTH, RWKV_HEADS, RWKV_HEAD), 0.1),
        "rw_ln_g": 1.0 + nrm((DEPTH, RWKV_DIM), 0.02),
        "rw_ln_b": nrm((DEPTH, RWKV_DIM), 0.02),
        "mla_qnorm_g": 1.0 + nrm((DEPTH, Q_LORA), 0.02),
        "mla_kvnorm_g": 1.0 + nrm((DEPTH, KV_LORA), 0.02),
        "mla_w_uq": nrm((DEPTH, Q_LORA, MLA_HEADS * (MLA_NOPE + MLA_ROPE)), Q_LORA ** -0.5),
        "mla_w_uk": nrm((DEPTH, KV_LORA, MLA_HEADS * MLA_NOPE), KV_LORA ** -0.5),
        "mla_w_uv": nrm((DEPTH, KV_LORA, MLA_HEADS * MLA_VHEAD), KV_LORA ** -0.5),
        "mla_qn_nope": 1.0 + nrm((DEPTH, MLA_NOPE), 0.02),
        "mla_qn_rope": 1.0 + nrm((DEPTH, MLA_ROPE), 0.02),
        "mla_kn_nope": 1.0 + nrm((DEPTH, MLA_NOPE), 0.02),
        "mla_kn_rope": 1.0 + nrm((DEPTH, MLA_ROPE), 0.02),
        "conv_w": nrm((DEPTH, CONV_W, CONV_DIM), CONV_W ** -0.5),
        "conv_b": nrm((DEPTH, CONV_DIM), 0.02),
        "w_out": nrm((DEPTH, MIX_DIM, D), MIX_DIM ** -0.5),
    }


def reference(x_prompt, x_sample, c_prompt, c_sample, cache_mla_latent, cache_mla_krope,
              state_rwkv, state_rwkv_shift, state_conv, w_ada, b_ada, norm_g, w_in,
              rw_mu, rw_w0, rw_w2, rw_a0, rw_a2, rw_kk, rw_ka, rw_rk, rw_ln_g, rw_ln_b,
              mla_qnorm_g, mla_kvnorm_g, mla_w_uq, mla_w_uk, mla_w_uv, mla_qn_nope,
              mla_qn_rope, mla_kn_nope, mla_kn_rope, conv_w, conv_b, w_out):
    yp, ys = x_prompt, x_sample
    Bp = x_prompt.shape[0]
    dt = x_prompt.dtype
    lat_p, kr_p, rw_p, sh_p, cv_p = [], [], [], [], []
    lat_s, kr_s, rw_s, sh_s, cv_s = [], [], [], [], []
    for l in range(DEPTH):
        lp = dict(w_ada=w_ada[l], b_ada=b_ada[l], norm_g=norm_g[l], w_in=w_in[l],
                  rw_mu=rw_mu[l], rw_w0=rw_w0[l], rw_w2=rw_w2[l], rw_a0=rw_a0[l],
                  rw_a2=rw_a2[l], rw_kk=rw_kk[l], rw_ka=rw_ka[l], rw_rk=rw_rk[l],
                  rw_ln_g=rw_ln_g[l], rw_ln_b=rw_ln_b[l], mla_qnorm_g=mla_qnorm_g[l],
                  mla_kvnorm_g=mla_kvnorm_g[l], mla_w_uq=mla_w_uq[l], mla_w_uk=mla_w_uk[l],
                  mla_w_uv=mla_w_uv[l], mla_qn_nope=mla_qn_nope[l], mla_qn_rope=mla_qn_rope[l],
                  mla_kn_nope=mla_kn_nope[l], mla_kn_rope=mla_kn_rope[l], conv_w=conv_w[l],
                  conv_b=conv_b[l], w_out=w_out[l])
        yp, lat, kr, rw, sh, cv = mixer_layer(
            yp, c_prompt,
            jnp.zeros((Bp, RWKV_HEADS, RWKV_HEAD, RWKV_HEAD), jnp.float32),
            jnp.zeros((Bp, RWKV_SHIFT_DIM), dt),
            jnp.zeros((Bp, CONV_W - 1, CONV_DIM), dt),
            jnp.zeros((Bp, 0, KV_LORA), dt),
            jnp.zeros((Bp, 0, MLA_ROPE), dt), **lp)
        lat_p.append(lat); kr_p.append(kr); rw_p.append(rw); sh_p.append(sh); cv_p.append(cv)
        ys, lat, kr, rw, sh, cv = mixer_layer(
            ys, c_sample, state_rwkv[l], state_rwkv_shift[l], state_conv[l],
            cache_mla_latent[l], cache_mla_krope[l], **lp)
        lat_s.append(lat); kr_s.append(kr); rw_s.append(rw); sh_s.append(sh); cv_s.append(cv)
    return (yp, ys,
            jnp.stack(lat_p), jnp.stack(kr_p), jnp.stack(rw_p), jnp.stack(sh_p), jnp.stack(cv_p),
            jnp.stack(lat_s), jnp.stack(kr_s), jnp.stack(rw_s), jnp.stack(sh_s), jnp.stack(cv_s))
```

```cpp
#include <hip/hip_runtime.h>
#include <cstdio>
#include <cstdint>

#ifndef MK_N_LAUNCHES
#define MK_N_LAUNCHES 1
#endif

#ifndef PROBE_DUP
#define PROBE_DUP -1
#endif
#define REPS(k) ((PROBE_DUP) == (k) ? 2 : 1)
#ifndef ATT_PROBE
#define ATT_PROBE 0
#endif
#ifndef EN_MASK
#define EN_MASK 0xFFFF
#endif
#define EN(k) (((EN_MASK) >> (k)) & 1)
#define GAS __attribute__((address_space(1)))
#define LAS __attribute__((address_space(3)))
typedef unsigned short bf16_t;
typedef short bf16x8 __attribute__((ext_vector_type(8)));
typedef short s16x4 __attribute__((ext_vector_type(4)));
typedef float f32x2 __attribute__((ext_vector_type(2)));
typedef float f32x4 __attribute__((ext_vector_type(4)));
typedef float f32x16 __attribute__((ext_vector_type(16)));
typedef unsigned u32x2 __attribute__((ext_vector_type(2)));
typedef unsigned u32x4 __attribute__((ext_vector_type(4)));

constexpr int DM = 4096, NB = 4, SEQ = 4096, DEPTH = 2, DB = 16, DS = 32, PAST = 2048;
constexpr int MP = NB * SEQ, MS = DB * DS, M = MP + MS;
constexpr int RW = 1024, SHIFT_DIM = 3200, QL = 1024, KVL = 512, ROPE = 64, MLAD = 2048, CONVD = 1024;
constexpr int IN_COLS = 11968, NPAD = 12032;
constexpr int C_RWGATE = 3200, C_CQ = 4224, C_CKV = 5248, C_KR = 5760, C_MGATE = 5824, C_CVB = 7872, C_CVC = 8896, C_CVX = 9920, C_CVG = 10944;
constexpr int SKEYS = PAST + DS;
constexpr int KROWS = MP + DB * SKEYS;
constexpr int QW = 3072;
constexpr float NORM_EPS = 1e-6f;
constexpr float QSCALE = 0.07216878364870323f * 1.4426950408889634f;
constexpr int REC = 1152;
constexpr int SREC_S0 = NB * 16 * SEQ;

constexpr size_t O_YP = 0, O_YS = 67108864, O_LATP = 69206016, O_KRP = 85983232, O_RWP = 88080384, O_SHP = 88604672, O_CVP = 88630272,
                 O_LATS = 88646656, O_KRS = 89170944, O_RWS = 89236480, O_SHS = 91333632, O_CVS = 91436032, O_END = 91501568;

constexpr size_t MiB = 1u << 20;
constexpr size_t WS_CTL = 0, CTL_ZERO_BYTES = 1 * MiB;
constexpr size_t WS_TAB = 1 * MiB;
constexpr size_t WS_MODP = 2 * MiB;
constexpr size_t WS_QIN = 2 * MiB;
constexpr size_t WS_MODF = 35 * MiB;
constexpr size_t WS_RKDOT = 37 * MiB;
constexpr size_t WS_W2P = 37 * MiB + 1280 * 1024;
constexpr size_t WS_WTIN = 39 * MiB;
constexpr size_t WS_OBUF = 39 * MiB;
constexpr size_t WS_WTOUT = 133 * MiB;
constexpr size_t WS_WTUQ = 165 * MiB;
constexpr size_t WS_WTUKV = 171 * MiB;
constexpr size_t WS_HMIX = 175 * MiB;
constexpr size_t WS_PROJ = 307 * MiB;
constexpr size_t WS_KN = WS_PROJ;
constexpr size_t WS_V = WS_PROJ + (size_t)KROWS * 2048 * 2;
constexpr size_t WS_SCAN = 696 * MiB;
constexpr size_t WS_PART = 994 * MiB;
constexpr size_t WS_Q = 1092 * MiB;
constexpr size_t WS_LAT = 1191 * MiB;
constexpr size_t WS_KR = 1240 * MiB;
constexpr size_t WS_CHK = 1247 * MiB;
constexpr size_t WS_END = 1496 * MiB;
static_assert(WS_V + (size_t)(KROWS + 64) * 2048 * 2 <= WS_SCAN, "ws map");
static_assert((KROWS / 256) * (2 * MLAD / 256) == 3104 && (M / 256) * (QW / 256) == 792, "KvOrder's unit counts");
static_assert(WS_PROJ + (size_t)M * NPAD * 2 <= WS_SCAN, "ws map");
static_assert(WS_SCAN + (size_t)(SREC_S0 + DB * 16 * DS) * REC <= WS_PART && WS_PART + (size_t)32 * 8 * 65536 * 4 <= WS_Q, "ws map");
static_assert(WS_CHK + (size_t)(NB * 16 * (SEQ / 16) + DB * 16 * (DS / 16)) * 15360 <= WS_END, "ws map");
static_assert(WS_RKDOT + (size_t)M * 16 * 4 <= WS_W2P && WS_W2P + 512 * 1024 <= WS_WTIN, "ws map");
static_assert(WS_OBUF + (size_t)M * RW * 4 <= WS_WTOUT && WS_QIN + (size_t)M * QL * 2 <= WS_MODF && WS_MODP + (size_t)2 * 11 * 20 * 12288 * 4 <= WS_MODF, "ws map");

constexpr int CW_BAR = 4096;
constexpr int CW_TICKET = 2048;

__device__ __forceinline__ float bflo(unsigned u) { return __uint_as_float(u << 16); }
__device__ __forceinline__ float bfhi(unsigned u) { return __uint_as_float(u & 0xffff0000u); }
__device__ __forceinline__ float bf2f(bf16_t b) { return __uint_as_float((unsigned)b << 16); }
__device__ __forceinline__ unsigned cvtpk(float lo, float hi) { unsigned r; asm volatile("v_cvt_pk_bf16_f32 %0, %1, %2" : "=v"(r) : "v"(lo), "v"(hi)); return r; }
__device__ __forceinline__ bf16_t f2bf(float f) { return (bf16_t)(cvtpk(f, 0.f) & 0xffffu); }
__device__ __forceinline__ float wave_sum(float v) {
#pragma unroll
    for (int o = 32; o >= 1; o >>= 1) v += __shfl_xor(v, o);
    return v;
}
__device__ __forceinline__ float sum16(float v) { v += __shfl_xor(v, 1); v += __shfl_xor(v, 2); v += __shfl_xor(v, 4); v += __shfl_xor(v, 8); return v; }
template <int CTRL> __device__ __forceinline__ float dppx_(float x) { return __int_as_float(__builtin_amdgcn_update_dpp(0, __float_as_int(x), CTRL, 0xf, 0xf, true)); }
__device__ __forceinline__ float sum32(float v) {
    v += dppx_<0xB1>(v); v += dppx_<0x4E>(v); v += dppx_<0x141>(v); v += dppx_<0x140>(v); v += __shfl_xor(v, 16); return v; }
typedef __bf16 bf16x2_t __attribute__((ext_vector_type(2)));
#define DOT2(a_, b_, c_) __builtin_amdgcn_fdot2_f32_bf16(__builtin_bit_cast(bf16x2_t, (unsigned)(a_)), __builtin_bit_cast(bf16x2_t, (unsigned)(b_)), (c_), false)
__device__ __forceinline__ float sigmoidf_(float x) { return __builtin_amdgcn_rcpf(1.0f + __expf(-x)); }
__device__ __forceinline__ float siluf_(float x) { return x * __builtin_amdgcn_rcpf(1.0f + __expf(-x)); }
__device__ __forceinline__ void unpack8(u32x4 u, float* f) {
    f[0] = bflo(u.x); f[1] = bfhi(u.x); f[2] = bflo(u.y); f[3] = bfhi(u.y); f[4] = bflo(u.z); f[5] = bfhi(u.z); f[6] = bflo(u.w); f[7] = bfhi(u.w);
}
__device__ __forceinline__ u32x4 pack8(const float* f) { u32x4 w; w.x = cvtpk(f[0], f[1]); w.y = cvtpk(f[2], f[3]); w.z = cvtpk(f[4], f[5]); w.w = cvtpk(f[6], f[7]); return w; }

__constant__ float ROPE_FREQ[32] = {
    1.000000000e+00f, 7.498942614e-01f, 5.623413324e-01f, 4.216965139e-01f, 3.162277639e-01f, 2.371373773e-01f, 1.778279394e-01f, 1.333521307e-01f,
    1.000000015e-01f, 7.498941571e-02f, 5.623413250e-02f, 4.216965288e-02f, 3.162277490e-02f, 2.371373773e-02f, 1.778279431e-02f, 1.333521493e-02f,
    9.999999776e-03f, 7.498941850e-03f, 5.623413250e-03f, 4.216964822e-03f, 3.162277630e-03f, 2.371373586e-03f, 1.778279431e-03f, 1.333521446e-03f,
    1.000000047e-03f, 7.498942432e-04f, 5.623413017e-04f, 4.216965172e-04f, 3.162277571e-04f, 2.371373703e-04f, 1.778279402e-04f, 1.333521504e-04f};

namespace pg8 {
#define PG8_LAS __attribute__((address_space(3)))
constexpr int BM = 256, BK = 64, HALF = 128, HTB = HALF * BK * 2, STAGE_BYTES = 8 * HTB, NXCD = 8, WGM = 8;
__host__ __device__ __forceinline__ int lds_byte(int r, int c) { const int st = (r >> 4) * 2 + (c >> 5), rr = r & 15, cc = c & 31, ob = rr * 64 + cc * 2; return st * 1024 + (ob ^ (((ob >> 9) & 1) << 5)); }
__host__ __device__ __forceinline__ void stage_rc(int b, int& R, int& C) { const int st = b / 1024, sb = b % 1024, swz = sb ^ (((sb >> 9) & 1) << 5); R = (st >> 1) * 16 + swz / 64; C = (st & 1) * 32 + (swz % 64) / 2; }
__host__ __device__ __forceinline__ int perm32(int rho) { const int n = rho >> 4, i = rho & 15; return 8 * (i >> 2) + 4 * n + (i & 3); }

struct Unit { int pm, pn; };
struct Gemm { const bf16_t* A; const bf16_t* Bt; int M, N, K; int ld; };

struct StaticOrder {
    int nM, nN, nwg, G, c;
    __host__ __device__ void init(int M_, int N_, int G_, int c_) { nM = M_ / BM; nN = N_ / BM; nwg = nM * nN; G = G_; c = c_; }
    __host__ __device__ bool next(int i, Unit& u) const {
        const long L = (long)i * G + c; if (L >= nwg) return false;
        int wgid = (int)L; { const int q = nwg / NXCD, r = nwg % NXCD, xcd = wgid % NXCD, off = wgid / NXCD; wgid = (xcd < r ? xcd * (q + 1) : r * (q + 1) + (xcd - r) * q) + off; }
        const int nig = WGM * nN, gid = wgid / nig, fm = gid * WGM, gsz = (nM - fm) < WGM ? (nM - fm) : WGM;
        u.pm = fm + ((wgid % nig) % gsz); u.pn = (wgid % nig) / gsz; return true;
    }
    __device__ __forceinline__ void a_ready(const Unit&) const {}
    __device__ __forceinline__ void done(const Unit&) const {}
};
struct KvOrder {
    int nM, nN, nwg, bx;
    __host__ __device__ void init(int M_, int N_, int bx_) { nM = M_ / BM; nN = N_ / BM; nwg = nM * nN; bx = bx_; }
    __host__ __device__ bool next(int i, Unit& u) const {
        const int gc = bx - 64; int L;
        if (i < 8) L = 256 * i + bx;
        else if (gc < 0) return false;
        else if (i < 12) L = 2048 + 192 * (i - 8) + gc;
        else if (gc < 24) return false;
        else if (i == 12) L = 2816 + (gc - 24);
        else if (i == 13 && gc - 24 < 120) L = 2984 + (gc - 24);
        else return false;
        int wgid = L; { const int q = nwg / NXCD, r = nwg % NXCD, xcd = wgid % NXCD, off = wgid / NXCD; wgid = (xcd < r ? xcd * (q + 1) : r * (q + 1) + (xcd - r) * q) + off; }
        const int nig = WGM * nN, gid = wgid / nig, fm = gid * WGM, gsz = (nM - fm) < WGM ? (nM - fm) : WGM;
        u.pm = fm + ((wgid % nig) % gsz); u.pn = (wgid % nig) / gsz; return true;
    }
    __device__ __forceinline__ void a_ready(const Unit&) const {}
    __device__ __forceinline__ void done(const Unit&) const {}
};

struct OneUnit {
    int pm, pn;
    __host__ __device__ bool next(int i, Unit& u) const { if (i) return false; u.pm = pm; u.pn = pn; return true; }
    __device__ __forceinline__ void a_ready(const Unit&) const {}
    __device__ __forceinline__ void done(const Unit&) const {}
};
struct EpiBf16 {
    static constexpr bool PERM = true, AFTER_DRAIN = false;
    bf16_t* O; int ldc; int split_cols; size_t split_stride;
    __device__ __forceinline__ void operator()(const f32x4 (&acc)[2][2][4][2], const Unit& u, int wr, int wc, int fr, int fq) const {
        const int row0 = u.pm * BM + wr * 64 + fr; int colt = u.pn * BM; bf16_t* base = O;
        if (split_cols) { const int t = colt / split_cols; base += (size_t)t * split_stride; colt -= t * split_cols; }
        const int col0 = colt + wc * 32 + 8 * fq;
#pragma unroll
        for (int ai = 0; ai < 2; ++ai)
#pragma unroll
            for (int m = 0; m < 4; ++m) { bf16_t* rowp = base + (size_t)(row0 + ai * HALF + m * 16) * ldc + col0;
#pragma unroll
                for (int bj = 0; bj < 2; ++bj) { const f32x4 v0 = acc[ai][bj][m][0], v1 = acc[ai][bj][m][1];
                    u32x4 w; w.x = cvtpk(v0[0], v0[1]); w.y = cvtpk(v0[2], v0[3]); w.z = cvtpk(v1[0], v1[1]); w.w = cvtpk(v1[2], v1[3]);
                    *(u32x4*)(rowp + bj * HALF) = w; } }
    }
};
struct EpiKV {
    static constexpr bool PERM = true, AFTER_DRAIN = false;
    bf16_t* Kn; bf16_t* V; const float* g; PG8_LAS float* xl;
    __device__ __forceinline__ void operator()(const f32x4 (&acc)[2][2][4][2], const Unit& u, int wr, int wc, int fr, int fq) const {
        const int row0 = u.pm * BM + wr * 64 + fr; const int colt = u.pn * BM;
        if (colt >= MLAD) {
            const int head0 = (colt - MLAD) >> 7;
            bf16_t* base = V + wc * 32 + 8 * fq;
#pragma unroll
            for (int ai = 0; ai < 2; ++ai)
#pragma unroll
                for (int m = 0; m < 4; ++m) { const size_t r = (size_t)(row0 + ai * HALF + m * 16);
#pragma unroll
                    for (int bj = 0; bj < 2; ++bj) { const f32x4 v0 = acc[ai][bj][m][0], v1 = acc[ai][bj][m][1];
                        u32x4 w; w.x = cvtpk(v0[0], v0[1]); w.y = cvtpk(v0[2], v0[3]); w.z = cvtpk(v1[0], v1[1]); w.w = cvtpk(v1[2], v1[3]);
                        *(u32x4*)(base + ((size_t)(head0 + bj) * KROWS + r) * 128) = w; } }
            return;
        }
        float ss[2][4][2];
#pragma unroll
        for (int ai = 0; ai < 2; ++ai)
#pragma unroll
            for (int m = 0; m < 4; ++m)
#pragma unroll
                for (int bj = 0; bj < 2; ++bj) { const f32x4 v0 = acc[ai][bj][m][0], v1 = acc[ai][bj][m][1];
                    float a = (v0[0] * v0[0] + v0[1] * v0[1]) + (v0[2] * v0[2] + v0[3] * v0[3]) + (v1[0] * v1[0] + v1[1] * v1[1]) + (v1[2] * v1[2] + v1[3] * v1[3]);
                    a += __shfl_xor(a, 16); a += __shfl_xor(a, 32);
                    ss[ai][m][bj] = a; }
        PG8_LAS float* mine = xl + (wr * 4 + wc) * 256;
        if (fq == 0) {
#pragma unroll
            for (int ai = 0; ai < 2; ++ai)
#pragma unroll
                for (int m = 0; m < 4; ++m)
#pragma unroll
                    for (int bj = 0; bj < 2; ++bj) mine[((ai * 4 + m) * 2 + bj) * 16 + fr] = ss[ai][m][bj];
        }
        asm volatile("s_waitcnt lgkmcnt(0)" ::: "memory"); __builtin_amdgcn_s_barrier(); asm volatile("" ::: "memory");
        const int colh = wc * 32 + 8 * fq;
        const f32x4 g0 = *(const f32x4*)(g + colh), g1 = *(const f32x4*)(g + colh + 4);
        const int head0 = colt >> 7;
        bf16_t* base = Kn + colh;
#pragma unroll
        for (int ai = 0; ai < 2; ++ai)
#pragma unroll
            for (int m = 0; m < 4; ++m) { const size_t r = (size_t)(row0 + ai * HALF + m * 16);
#pragma unroll
                for (int bj = 0; bj < 2; ++bj) {
                    const int slot = ((ai * 4 + m) * 2 + bj) * 16 + fr;
                    const float tot = (xl[(wr * 4 + 0) * 256 + slot] + xl[(wr * 4 + 1) * 256 + slot]) + (xl[(wr * 4 + 2) * 256 + slot] + xl[(wr * 4 + 3) * 256 + slot]);
                    const float rs = rsqrtf(tot * (1.f / 128) + NORM_EPS);
                    const f32x4 v0 = acc[ai][bj][m][0] * rs * g0, v1 = acc[ai][bj][m][1] * rs * g1;
                    u32x4 w; w.x = cvtpk(v0[0], v0[1]); w.y = cvtpk(v0[2], v0[3]); w.z = cvtpk(v1[0], v1[1]); w.w = cvtpk(v1[2], v1[3]);
                    *(u32x4*)(base + ((size_t)(head0 + bj) * KROWS + r) * 128) = w; } }
    }
};
struct EpiPart {
    static constexpr bool PERM = false, AFTER_DRAIN = false;
    float* P;
    __device__ __forceinline__ void operator()(const f32x4 (&acc)[2][2][4][2], const Unit&, int wr, int wc, int fr, int fq) const {
        const int col0 = wc * 32 + 4 * fq;
#pragma unroll
        for (int ai = 0; ai < 2; ++ai)
#pragma unroll
            for (int m = 0; m < 4; ++m) { float* prow = P + (size_t)(ai * HALF + wr * 64 + m * 16 + fr) * BM + col0;
#pragma unroll
                for (int bj = 0; bj < 2; ++bj)
#pragma unroll
                    for (int n = 0; n < 2; ++n) *(f32x4*)(prow + bj * HALF + n * 16) = acc[ai][bj][m][n]; }
    }
};
struct EpiResGate {
    static constexpr bool PERM = false, AFTER_DRAIN = false;
    const float* xp; const float* xs; float* out; const float* gate;
    __device__ __forceinline__ void operator()(const f32x4 (&acc)[2][2][4][2], const Unit& u, int wr, int wc, int fr, int fq) const {
        const int col0 = u.pn * BM + wc * 32 + 4 * fq;
#pragma unroll
        for (int ai = 0; ai < 2; ++ai)
#pragma unroll
            for (int m = 0; m < 4; ++m) {
                const int r = u.pm * BM + ai * HALF + wr * 64 + m * 16 + fr;
                const int seq = r < MP ? (r >> 12) : 4 + ((r - MP) >> 5);
                const float* xr = r < MP ? xp + (size_t)r * DM : xs + (size_t)(r - MP) * DM;
                const float* gr = gate + (size_t)seq * (3 * DM);
                float* orow = out + (size_t)r * DM;
                f32x4 xv4[4], gv4[4];
#pragma unroll
                for (int q = 0; q < 4; ++q) { const int c = col0 + (q >> 1) * HALF + (q & 1) * 16; xv4[q] = *(const f32x4*)(xr + c); gv4[q] = *(const f32x4*)(gr + c); }
#pragma unroll
                for (int q = 0; q < 4; ++q) { const int c = col0 + (q >> 1) * HALF + (q & 1) * 16; *(f32x4*)(orow + c) = xv4[q] + gv4[q] * acc[ai][q >> 1][m][q & 1]; }
            }
    }
};

template <class Epi, class Sched, bool ALIGN_EPI = false, bool SP2 = false>
__device__ __forceinline__ void gemm_phase(PG8_LAS unsigned char* lds, const Gemm g, const Sched& S, const Epi& E) {
    int tid_ = threadIdx.x; asm volatile("" : "+v"(tid_));
    const int tid = tid_, wid = __builtin_amdgcn_readfirstlane(tid >> 6), lane = tid & 63, wr = wid >> 2, wc = wid & 3, fr = lane & 15, fq = lane >> 4;
    const int K = g.K, LD = g.ld ? g.ld : g.K, nt = K / BK;
    unsigned voffA[2], voffB[2];
#pragma unroll
    for (int i = 0; i < 2; ++i) { int R, C; stage_rc(tid * 16 + i * 8192, R, C); const int Rb = Epi::PERM ? ((R & ~31) + perm32(R & 31)) : R;
        voffA[i] = (unsigned)(R * LD + C) * 2u; voffB[i] = (unsigned)(Rb * LD + C) * 2u; }
    const size_t kstep = (size_t)(BK * 2);
    const size_t hstep = (size_t)HALF * LD * 2;
    const size_t tstep = 2 * hstep;
    const unsigned ldsw = (unsigned)wid * 1024u;
    const int aoff = lds_byte(wr * 64 + fr, fq * 8), boff = lds_byte(wc * 32 + fr, fq * 8);
#define PG8_SA(b, h) (((b) * 2 + (h)) * HTB)
#define PG8_SB(b, h) ((4 + (b) * 2 + (h)) * HTB)
#define PG8_STAGE(bufoff, gbase, voff) do { _Pragma("unroll") for (int _i = 0; _i < 2; ++_i) \
        __builtin_amdgcn_global_load_lds((const unsigned*)((const char*)(gbase) + (voff)[_i]), (PG8_LAS unsigned*)(lds + (bufoff) + ldsw + _i * 8192), 16, 0, 0); } while (0)
#define PG8_LDA(dst, b, h) do { _Pragma("unroll") for (int m = 0; m < 4; ++m) _Pragma("unroll") for (int k = 0; k < 2; ++k) dst[m][k] = *(const PG8_LAS bf16x8*)(lds + PG8_SA(b, h) + aoff + m * 2048 + k * 1024); } while (0)
#define PG8_LDB(dst, b, h) do { _Pragma("unroll") for (int n = 0; n < 2; ++n) _Pragma("unroll") for (int k = 0; k < 2; ++k) dst[n][k] = *(const PG8_LAS bf16x8*)(lds + PG8_SB(b, h) + boff + n * 2048 + k * 1024); } while (0)
#define PG8_MMA(ai, bj, At, Bt) do { __builtin_amdgcn_s_setprio(1); _Pragma("unroll") for (int m = 0; m < 4; ++m) _Pragma("unroll") for (int n = 0; n < 2; ++n) _Pragma("unroll") for (int k = 0; k < 2; ++k) \
        acc[ai][bj][m][n] = __builtin_amdgcn_mfma_f32_16x16x32_bf16(Bt[n][k], At[m][k], acc[ai][bj][m][n], 0, 0, 0); __builtin_amdgcn_s_setprio(0); } while (0)
#define PG8_WAIT_V(n) asm volatile("s_waitcnt vmcnt(" #n ")" ::: "memory")
#define PG8_WAIT_L(n) asm volatile("s_waitcnt lgkmcnt(" #n ")" ::: "memory")
#define PG8_BAR __builtin_amdgcn_s_barrier()
#define PG8_SCHED __builtin_amdgcn_sched_barrier(0)
    Unit cur, nxt; int ui = 0;
    if (!S.next(0, cur)) return;
    f32x4 acc[2][2][4][2];
#pragma unroll
    for (int a = 0; a < 2; ++a)
#pragma unroll
        for (int b = 0; b < 2; ++b)
#pragma unroll
            for (int m = 0; m < 4; ++m)
#pragma unroll
                for (int n = 0; n < 2; ++n) acc[a][b][m][n] = (f32x4){0.f, 0.f, 0.f, 0.f};
    bf16x8 At[4][2], B0[2][2], B1[2][2];
    const char* cA = (const char*)g.A + (size_t)cur.pm * tstep; const char* cB = (const char*)g.Bt + (size_t)cur.pn * tstep;
    S.a_ready(cur);
    if constexpr (SP2) {
        PG8_STAGE(PG8_SB(0, 0), cB, voffB); PG8_STAGE(PG8_SB(0, 1), cB + hstep, voffB); PG8_STAGE(PG8_SA(0, 0), cA, voffA); PG8_STAGE(PG8_SA(0, 1), cA + hstep, voffA);
        if (wr == 1) PG8_BAR;
        PG8_WAIT_V(2); PG8_BAR;
        PG8_STAGE(PG8_SB(1, 0), cB + kstep, voffB); PG8_STAGE(PG8_SA(1, 0), cA + kstep, voffA); PG8_STAGE(PG8_SB(1, 1), cB + hstep + kstep, voffB);
        PG8_WAIT_V(6); PG8_BAR;
    } else {
        PG8_STAGE(PG8_SB(0, 0), cB, voffB); PG8_STAGE(PG8_SA(0, 0), cA, voffA); PG8_STAGE(PG8_SB(0, 1), cB + hstep, voffB); PG8_STAGE(PG8_SA(0, 1), cA + hstep, voffA);
        if (wr == 1) PG8_BAR;
        PG8_WAIT_V(4); PG8_BAR;
        PG8_STAGE(PG8_SB(1, 0), cB + kstep, voffB); PG8_STAGE(PG8_SA(1, 0), cA + kstep, voffA); PG8_STAGE(PG8_SB(1, 1), cB + hstep + kstep, voffB);
        PG8_WAIT_V(6); PG8_BAR;
    }
    for (;;) {
        const bool has_next = S.next(ui + 1, nxt);
        const char* nA = has_next ? (const char*)g.A + (size_t)nxt.pm * tstep : cA; const char* nB = has_next ? (const char*)g.Bt + (size_t)nxt.pn * tstep : cB;
        for (int t = 0; t < nt; t += 2) {
            const bool last = (t == nt - 2);
            const char* a1 = cA + (size_t)(t + 1) * kstep;
            const char* a2 = last ? nA : cA + (size_t)(t + 2) * kstep; const char* b2 = last ? nB : cB + (size_t)(t + 2) * kstep;
            const char* a3 = a2 + kstep; const char* b3 = b2 + kstep;
            if (last && has_next) S.a_ready(nxt);
            if constexpr (SP2) {
            PG8_LDB(B0, 0, 0); PG8_LDB(B1, 0, 1); PG8_SCHED; PG8_LDA(At, 0, 0); PG8_STAGE(PG8_SA(1, 1), a1 + hstep, voffA);
            PG8_WAIT_V(8); PG8_WAIT_L(0); PG8_BAR; PG8_MMA(0, 0, At, B0); PG8_MMA(0, 1, At, B1); PG8_BAR; PG8_SCHED;
            PG8_LDA(At, 0, 1); PG8_STAGE(PG8_SB(0, 0), b2, voffB); PG8_STAGE(PG8_SB(0, 1), b2 + hstep, voffB); PG8_STAGE(PG8_SA(0, 0), a2, voffA);
            PG8_WAIT_V(8); PG8_WAIT_L(0); PG8_BAR; PG8_MMA(1, 0, At, B0); PG8_MMA(1, 1, At, B1); PG8_BAR; PG8_SCHED;
            PG8_LDB(B0, 1, 0); PG8_LDB(B1, 1, 1); PG8_SCHED; PG8_LDA(At, 1, 0); PG8_STAGE(PG8_SA(0, 1), a2 + hstep, voffA);
            PG8_WAIT_V(8); PG8_WAIT_L(0); PG8_BAR; PG8_MMA(0, 0, At, B0); PG8_MMA(0, 1, At, B1); PG8_BAR; PG8_SCHED;
            PG8_LDA(At, 1, 1); PG8_STAGE(PG8_SB(1, 0), b3, voffB); PG8_STAGE(PG8_SB(1, 1), b3 + hstep, voffB); PG8_STAGE(PG8_SA(1, 0), a3, voffA);
            PG8_WAIT_V(8); PG8_WAIT_L(0); PG8_BAR; PG8_MMA(1, 0, At, B0); PG8_MMA(1, 1, At, B1); PG8_BAR; PG8_SCHED;
            } else {
            PG8_LDB(B0, 0, 0); PG8_SCHED; PG8_LDA(At, 0, 0); PG8_STAGE(PG8_SA(1, 1), a1 + hstep, voffA);
            PG8_WAIT_L(8); PG8_BAR; PG8_WAIT_L(0); PG8_MMA(0, 0, At, B0); PG8_BAR; PG8_SCHED;
            PG8_LDB(B1, 0, 1); PG8_STAGE(PG8_SB(0, 0), b2, voffB);
            PG8_BAR; PG8_WAIT_L(0); PG8_MMA(0, 1, At, B1); PG8_BAR;
            PG8_LDA(At, 0, 1); PG8_STAGE(PG8_SA(0, 0), a2, voffA);
            PG8_BAR; PG8_WAIT_L(0); PG8_MMA(1, 0, At, B0); PG8_BAR; PG8_SCHED;
            PG8_STAGE(PG8_SB(0, 1), b2 + hstep, voffB);
            PG8_WAIT_V(6); PG8_BAR; PG8_MMA(1, 1, At, B1); PG8_BAR;
            PG8_LDB(B0, 1, 0); PG8_SCHED; PG8_LDA(At, 1, 0); PG8_STAGE(PG8_SA(0, 1), a2 + hstep, voffA);
            PG8_WAIT_L(8); PG8_BAR; PG8_WAIT_L(0); PG8_MMA(0, 0, At, B0); PG8_BAR; PG8_SCHED;
            PG8_LDB(B1, 1, 1); PG8_STAGE(PG8_SB(1, 0), b3, voffB);
            PG8_BAR; PG8_WAIT_L(0); PG8_MMA(0, 1, At, B1); PG8_BAR;
            PG8_LDA(At, 1, 1); PG8_STAGE(PG8_SA(1, 0), a3, voffA);
            PG8_BAR; PG8_WAIT_L(0); PG8_MMA(1, 0, At, B0); PG8_BAR; PG8_SCHED;
            PG8_STAGE(PG8_SB(1, 1), b3 + hstep, voffB);
            PG8_WAIT_V(6); PG8_BAR; PG8_MMA(1, 1, At, B1); PG8_BAR;
            }
        }
        if constexpr (ALIGN_EPI) { if (wr == 0) PG8_BAR; }
        if constexpr (!Epi::AFTER_DRAIN) { E(acc, cur, wr, wc, fr, fq); S.done(cur); }
        if (!has_next) break;
#pragma unroll
        for (int a = 0; a < 2; ++a)
#pragma unroll
            for (int b = 0; b < 2; ++b)
#pragma unroll
                for (int m = 0; m < 4; ++m)
#pragma unroll
                    for (int n = 0; n < 2; ++n) acc[a][b][m][n] = (f32x4){0.f, 0.f, 0.f, 0.f};
        cur = nxt; cA = nA; cB = nB; ++ui;
        if constexpr (ALIGN_EPI) { if (wr == 1) PG8_BAR; }
    }
    PG8_WAIT_V(0);
    if constexpr (!ALIGN_EPI) { if (wr == 0) PG8_BAR; }
    PG8_BAR;
#undef PG8_SA
#undef PG8_SB
#undef PG8_STAGE
#undef PG8_LDA
#undef PG8_LDB
#undef PG8_MMA
#undef PG8_WAIT_V
#undef PG8_WAIT_L
#undef PG8_BAR
#undef PG8_SCHED
}
}

#define XB_TMO      128
#define XB_XCNT(j)  (256  + 64 * (j))
#define XB_XSUB(j)  (1280 + 64 * (j))
#define XB_XGEN(j)  (2304 + 64 * (j))
#define XB_TOP      3328
#define XB_TOPGEN   3392
#define XCD_BAR_WORDS 3456
#define XB_SPIN_CAP (1u << 18)
__device__ __forceinline__ unsigned xb_ld(unsigned* p)              { return __hip_atomic_load(p, __ATOMIC_RELAXED, __HIP_MEMORY_SCOPE_AGENT); }
__device__ __forceinline__ unsigned xb_add(unsigned* p, unsigned v) { return __hip_atomic_fetch_add(p, v, __ATOMIC_RELAXED, __HIP_MEMORY_SCOPE_AGENT); }
__device__ __forceinline__ unsigned xb_xcc_id() { return (unsigned)__builtin_amdgcn_s_getreg((3 << 11) | 20) & 0xFu; }
#define XB_SPIN(cond, bar) do { unsigned _sp = 0; while (cond) { __builtin_amdgcn_s_sleep(1); \
    if ((++_sp & 255u) == 0u) { if (xb_ld(&(bar)[XB_TMO])) break; if (_sp > XB_SPIN_CAP) { atomicAdd(&(bar)[XB_TMO], 1u); break; } } } } while (0)
struct XcdBarrier { unsigned* bar; unsigned x; volatile LAS unsigned* st; };
__device__ __forceinline__ XcdBarrier xcd_barrier_post(unsigned* bar, volatile LAS unsigned* st) {
    XcdBarrier b; b.bar = bar; b.x = xb_xcc_id(); b.st = st;
    if (threadIdx.x == 0) (void)xb_add(&bar[XB_XCNT(b.x)], 1u);
    return b;
}
__device__ __forceinline__ void xcd_barrier_complete(unsigned* bar, unsigned x, unsigned& nloc, unsigned& nx) {
    const unsigned G = gridDim.x * gridDim.y * gridDim.z;
    unsigned sum, cnt, mine, sp = 0u;
    for (;;) {
        sum = 0u; cnt = 0u; mine = 0u;
#pragma unroll
        for (unsigned j = 0; j < 16; ++j) { const unsigned c = xb_ld(&bar[XB_XCNT(j)]); sum += c; cnt += (c > 0u) ? 1u : 0u; mine = (j == x) ? c : mine; }
        if (sum == G) break;
        __builtin_amdgcn_s_sleep(1);
        if ((++sp & 255u) == 0u) { if (xb_ld(&bar[XB_TMO])) break; if (sp > XB_SPIN_CAP) { atomicAdd(&bar[XB_TMO], 1u); break; } }
    }
    nloc = mine > 0u ? mine : 1u; nx = cnt > 0u ? cnt : 1u;
}
__device__ __forceinline__ void xcd_barrier(const XcdBarrier& b) {
    asm volatile("s_waitcnt vmcnt(0)" ::: "memory");
    __syncthreads();
    if (threadIdx.x == 0) {
        unsigned* bar = b.bar;
        __builtin_amdgcn_s_waitcnt(0);
        unsigned nloc = b.st[0], nx = b.st[1];
        if (nloc == 0u) { xcd_barrier_complete(bar, b.x, nloc, nx); b.st[0] = nloc; b.st[1] = nx; }
        const unsigned old = xb_add(&bar[XB_XSUB(b.x)], 1u);
        const unsigned gen = old / nloc;
        if (old + 1u == (gen + 1u) * nloc) {
            __builtin_amdgcn_fence(__ATOMIC_RELEASE, "agent");
            asm volatile("s_waitcnt vmcnt(0)" ::: "memory");
            const unsigned og = xb_add(&bar[XB_TOP], 1u);
            const unsigned tg = og / nx;
            if (og + 1u == (tg + 1u) * nx) xb_add(&bar[XB_TOPGEN], 1u);
            else XB_SPIN(xb_ld(&bar[XB_TOPGEN]) == tg, bar);
            __builtin_amdgcn_fence(__ATOMIC_ACQUIRE, "agent");
            xb_add(&bar[XB_XGEN(b.x)], 1u);
            asm volatile("s_waitcnt vmcnt(0)" ::: "memory");
        } else {
            XB_SPIN(xb_ld(&bar[XB_XGEN(b.x)]) == gen, bar);
            __builtin_amdgcn_fence(__ATOMIC_ACQUIRE, "agent");
            asm volatile("s_waitcnt vmcnt(0)" ::: "memory");
        }
    }
    __syncthreads();
}

namespace att {
constexpr int SHM_V = 16384, SHM_KN = 16384, SHM_KR = 8192, KSTRIDE = SHM_KN + SHM_KR;
constexpr int OFF_V = 0, OFF_K = 2 * SHM_V, OFF_WS = OFF_K + 2 * KSTRIDE, LDS_BYTES = OFF_WS + 8 * 64 * 4;
#define KSWZ(row, colB) ((row) * 256 + ((colB) ^ (((row) & 15) << 4)))
#define KRSWZ(row, colB) ((row) * 128 + ((colB) ^ ((((row) >> 1) & 7) << 4)))
#define SBAR() __builtin_amdgcn_sched_barrier(0)
__device__ __forceinline__ int v_st(int k, int c) { const int kk = (k & ~0xC) | ((k & 4) << 1) | ((k & 8) >> 1); return ((kk >> 3) * 4 + (c >> 5)) * 512 + ((kk & 7) * 32 + (c & 31)) * 2; }
__device__ __forceinline__ int v_rd_base(int lane) { return ((lane & 3) << 3) | (((lane >> 2) & 3) << 6) | (((lane >> 4) & 1) << 5) | (((lane >> 5) & 1) << 8); }
constexpr int v_rd_off(int d0, int ks, int half) { return d0 * 512 + ks * 4096 + half * 2048; }
__device__ __forceinline__ int crow(int r, int hi) { return (r & 3) + 8 * (r >> 2) + 4 * hi; }

struct AUnit { const bf16_t* Q; const bf16_t* Kn; const bf16_t* V; const bf16_t* Kr; bf16_t* O; int nt, nwav, jbase, lastmask; int pos0; const float* gqn; const float* gqr; const float2* tab; };

template <int KB>
__device__ __forceinline__ void qkt(f32x16& p0, f32x16& p1, LAS const char* lds, int r32, int hi, const bf16x8* qr) {
    p0 = f32x16{}; p1 = f32x16{};
    LAS const char* kn = lds + OFF_K + KB * KSTRIDE;
    LAS const char* kr = kn + SHM_KN;
#pragma unroll
    for (int d0 = 0; d0 < 8; ++d0) {
        LAS const char* a = kn + KSWZ(r32, (d0 * 16 + hi * 8) * 2);
        const bf16x8 b0 = *(LAS const bf16x8*)a;
        const bf16x8 b1 = *(LAS const bf16x8*)(a + 32 * 256);
        p0 = __builtin_amdgcn_mfma_f32_32x32x16_bf16(b0, qr[d0], p0, 0, 0, 0);
        p1 = __builtin_amdgcn_mfma_f32_32x32x16_bf16(b1, qr[d0], p1, 0, 0, 0);
    }
#pragma unroll
    for (int d0 = 0; d0 < 4; ++d0) {
        LAS const char* a = kr + KRSWZ(r32, (d0 * 16 + hi * 8) * 2);
        const bf16x8 b0 = *(LAS const bf16x8*)a;
        const bf16x8 b1 = *(LAS const bf16x8*)(a + 32 * 128);
        p0 = __builtin_amdgcn_mfma_f32_32x32x16_bf16(b0, qr[8 + d0], p0, 0, 0, 0);
        p1 = __builtin_amdgcn_mfma_f32_32x32x16_bf16(b1, qr[8 + d0], p1, 0, 0, 0);
    }
}
template <int VB>
__device__ __forceinline__ void pv_tile(f32x16* o, int vb0, bf16x8 pa0, bf16x8 pa1, bf16x8 pa2, bf16x8 pa3) {
#define TRRD(dst, off) asm volatile("ds_read_b64_tr_b16 %0, %1 offset:%2" : "=&v"(dst) : "v"(vb0), "i"(off) : "memory")
#define PV_D0(d0) do { s16x4 l0, l1, l2, l3, h0, h1, h2, h3; constexpr int b_ = OFF_V + VB * SHM_V + v_rd_off(d0, 0, 0); \
        TRRD(l0, b_); TRRD(h0, b_ + 2048); TRRD(l1, b_ + 4096); TRRD(h1, b_ + 6144); TRRD(l2, b_ + 8192); TRRD(h2, b_ + 10240); TRRD(l3, b_ + 12288); TRRD(h3, b_ + 14336); \
        asm volatile("s_waitcnt lgkmcnt(0)" ::: "memory"); SBAR(); \
        o[d0] = __builtin_amdgcn_mfma_f32_32x32x16_bf16(pa0, (bf16x8){l0[0], l0[1], l0[2], l0[3], h0[0], h0[1], h0[2], h0[3]}, o[d0], 0, 0, 0);   \
        o[d0] = __builtin_amdgcn_mfma_f32_32x32x16_bf16(pa1, (bf16x8){l1[0], l1[1], l1[2], l1[3], h1[0], h1[1], h1[2], h1[3]}, o[d0], 0, 0, 0);   \
        o[d0] = __builtin_amdgcn_mfma_f32_32x32x16_bf16(pa2, (bf16x8){l2[0], l2[1], l2[2], l2[3], h2[0], h2[1], h2[2], h2[3]}, o[d0], 0, 0, 0);   \
        o[d0] = __builtin_amdgcn_mfma_f32_32x32x16_bf16(pa3, (bf16x8){l3[0], l3[1], l3[2], l3[3], h3[0], h3[1], h3[2], h3[3]}, o[d0], 0, 0, 0); } while (0)
    PV_D0(0); PV_D0(1); PV_D0(2); PV_D0(3);
#undef PV_D0
#undef TRRD
}

template <int VAR>
__device__ __forceinline__ void attn_unit(const AUnit& u, LAS char* lds) {
    int tid_ = threadIdx.x; asm volatile("" : "+v"(tid_));
    const int tid = tid_, wid = __builtin_amdgcn_readfirstlane(tid >> 6), lane = tid & 63, r32 = lane & 31, hi = lane >> 5;
    const bool wact = wid < u.nwav;
    const int jmax = u.jbase + (wid >> 1);
    const bf16_t* gk0; const bf16_t* gk1; const bf16_t* gkr; const bf16_t* gv0; const bf16_t* gv1;
    {
        const int rk0 = (2 * wid) * 4 + (lane >> 4), rk1 = rk0 + 4, ph = lane & 15;
        gk0 = u.Kn + (size_t)rk0 * 128 + ((ph ^ (rk0 & 15)) * 8);
        gk1 = u.Kn + (size_t)rk1 * 128 + ((ph ^ (rk1 & 15)) * 8);
        const int rr0 = wid * 8 + (lane >> 3), pr = lane & 7;
        gkr = u.Kr + (size_t)rr0 * ROPE + ((pr ^ ((rr0 >> 1) & 7)) * 8);
#pragma unroll
        for (int i = 0; i < 2; ++i) {
            const int st = (2 * wid + i) * 2 + (lane >> 5), o16 = lane & 31, kk = (st >> 2) * 8 + (o16 >> 2), c = (st & 3) * 32 + (o16 & 3) * 8;
            const int key = (kk & ~0xC) | ((kk & 4) << 1) | ((kk & 8) >> 1);
            const bf16_t* p = u.V + (size_t)key * 128 + c;
            if (i == 0) gv0 = p; else gv1 = p;
        }
    }
#define ADMA(t, bf) do { const size_t ro = (size_t)(t) * 64; LAS char* kb_ = lds + OFF_K + (bf) * KSTRIDE; LAS char* vb_ = lds + OFF_V + (bf) * SHM_V; \
        __builtin_amdgcn_global_load_lds((const unsigned*)(gk0 + ro * 128), (LAS unsigned*)(kb_ + (2 * wid) * 1024), 16, 0, 0); \
        __builtin_amdgcn_global_load_lds((const unsigned*)(gk1 + ro * 128), (LAS unsigned*)(kb_ + (2 * wid + 1) * 1024), 16, 0, 0); \
        __builtin_amdgcn_global_load_lds((const unsigned*)(gkr + ro * ROPE), (LAS unsigned*)(kb_ + SHM_KN + wid * 1024), 16, 0, 0); \
        __builtin_amdgcn_global_load_lds((const unsigned*)(gv0 + ro * 128), (LAS unsigned*)(vb_ + (2 * wid) * 1024), 16, 0, 0); \
        __builtin_amdgcn_global_load_lds((const unsigned*)(gv1 + ro * 128), (LAS unsigned*)(vb_ + (2 * wid + 1) * 1024), 16, 0, 0); } while (0)
#define AWAITV() asm volatile("s_waitcnt vmcnt(0)" ::: "memory")
    ADMA(0, 0);
    bf16x8 qr[12];
    {
        const int wq = wact ? wid : 0;
        const bf16_t* qp = u.Q + (size_t)(wq * 32 + r32) * QW + hi * 8;
#pragma unroll
        for (int d0 = 0; d0 < 12; ++d0) qr[d0] = *(const bf16x8*)(qp + d0 * 16);
        float ssn = 0.f, ssr = 0.f;
#pragma unroll
        for (int d0 = 0; d0 < 12; ++d0) { float f[8]; unpack8(__builtin_bit_cast(u32x4, qr[d0]), f); float a = 0.f;
#pragma unroll
            for (int e = 0; e < 8; ++e) a += f[e] * f[e];
            if (d0 < 8) ssn += a; else ssr += a; }
        { auto rr = __builtin_amdgcn_permlane32_swap(__float_as_uint(ssn), __float_as_uint(ssn), false, false); ssn = __uint_as_float(rr[0]) + __uint_as_float(rr[1]); }
        { auto rr = __builtin_amdgcn_permlane32_swap(__float_as_uint(ssr), __float_as_uint(ssr), false, false); ssr = __uint_as_float(rr[0]) + __uint_as_float(rr[1]); }
        const float rn = rsqrtf(ssn * (1.f / 128) + NORM_EPS) * QSCALE, rr_ = rsqrtf(ssr * (1.f / ROPE) + NORM_EPS);
#pragma unroll
        for (int d0 = 0; d0 < 8; ++d0) { float f[8]; unpack8(__builtin_bit_cast(u32x4, qr[d0]), f);
            const f32x4 g0 = *(const f32x4*)(u.gqn + d0 * 16 + hi * 8), g1 = *(const f32x4*)(u.gqn + d0 * 16 + hi * 8 + 4);
#pragma unroll
            for (int e = 0; e < 4; ++e) { f[e] *= rn * g0[e]; f[4 + e] *= rn * g1[e]; }
            qr[d0] = __builtin_bit_cast(bf16x8, pack8(f)); }
        const int pos = u.pos0 + wq * 32 + r32;
#pragma unroll
        for (int a = 0; a < 2; ++a) { float x1[8], x2[8]; unpack8(__builtin_bit_cast(u32x4, qr[8 + a]), x1); unpack8(__builtin_bit_cast(u32x4, qr[10 + a]), x2);
            const int i0 = a * 16 + hi * 8;
            const f32x4 ga0 = *(const f32x4*)(u.gqr + i0), ga1 = *(const f32x4*)(u.gqr + i0 + 4), gb0 = *(const f32x4*)(u.gqr + 32 + i0), gb1 = *(const f32x4*)(u.gqr + 32 + i0 + 4);
            float y1[8], y2[8];
#pragma unroll
            for (int e = 0; e < 8; ++e) { const float v1 = x1[e] * rr_ * (e < 4 ? ga0[e & 3] : ga1[e & 3]), v2 = x2[e] * rr_ * (e < 4 ? gb0[e & 3] : gb1[e & 3]);
                const float2 cs = u.tab[pos * 32 + i0 + e];
                y1[e] = (v1 * cs.x - v2 * cs.y) * QSCALE; y2[e] = (v2 * cs.x + v1 * cs.y) * QSCALE; }
            qr[8 + a] = __builtin_bit_cast(bf16x8, pack8(y1)); qr[10 + a] = __builtin_bit_cast(bf16x8, pack8(y2)); }
    }
    float m_reg = -1e30f, l_reg = 0.f; f32x16 o[4]; o[0] = f32x16{}; o[1] = f32x16{}; o[2] = f32x16{}; o[3] = f32x16{};
    LAS float* wsf = (LAS float*)(lds + OFF_WS) + wid * 64; LAS float* li_l = wsf; LAS float* al_l = wsf + 32;
    const int vb0 = (int)(unsigned)(uintptr_t)lds + v_rd_base(lane);
    AWAITV();
    __syncthreads();
#define ASTEP(BF, j) do { const int j_ = (j); const bool more_ = (VAR != 2) && (j_ + 1 < u.nt); \
        if (more_) ADMA(j_ + 1, (BF) ^ 1); \
        if (wact && j_ <= jmax) { \
            f32x16 p0, p1; if (VAR == 3) { _Pragma("unroll") for (int r = 0; r < 16; ++r) { p0[r] = (float)(r + j_) * 0.01f; p1[r] = (float)(r32 + r) * 0.01f; } } else qkt<BF>(p0, p1, lds, r32, hi, qr); \
            if (u.lastmask && j_ == u.nt - 1) { _Pragma("unroll") for (int r = 0; r < 16; ++r) p1[r] = -__builtin_inff(); } \
            if (VAR != 1) { \
            float pmax = p0[0]; _Pragma("unroll") for (int r = 1; r < 16; ++r) pmax = fmaxf(pmax, p0[r]); _Pragma("unroll") for (int r = 0; r < 16; ++r) pmax = fmaxf(pmax, p1[r]); \
            { auto rr = __builtin_amdgcn_permlane32_swap(__float_as_uint(pmax), __float_as_uint(pmax), false, false); pmax = fmaxf(__uint_as_float(rr[0]), __uint_as_float(rr[1])); } \
            const float mn = fmaxf(m_reg, pmax); const float alpha = __builtin_amdgcn_exp2f(m_reg - mn); m_reg = mn; \
            _Pragma("unroll") for (int r = 0; r < 16; ++r) { p0[r] = __builtin_amdgcn_exp2f(p0[r] - mn); p1[r] = __builtin_amdgcn_exp2f(p1[r] - mn); } \
            float ps = 0.f; _Pragma("unroll") for (int r = 0; r < 16; ++r) ps += p0[r]; _Pragma("unroll") for (int r = 0; r < 16; ++r) ps += p1[r]; \
            { auto rr = __builtin_amdgcn_permlane32_swap(__float_as_uint(ps), __float_as_uint(ps), false, false); ps = __uint_as_float(rr[0]) + __uint_as_float(rr[1]); } \
            l_reg = l_reg * alpha + ps; \
            if (__any(alpha < 1.f)) { if (hi == 0) al_l[r32] = alpha; asm volatile("s_waitcnt lgkmcnt(0)" ::: "memory"); \
                _Pragma("unroll") for (int d_ = 0; d_ < 4; ++d_) _Pragma("unroll") for (int r = 0; r < 16; ++r) o[d_][r] *= al_l[crow(r, hi)]; } \
            } \
            bf16x8 pa0, pa1, pa2, pa3; \
            APK4(p0, 0, pa0); APK4(p0, 8, pa1); APK4(p1, 0, pa2); APK4(p1, 8, pa3); \
            SBAR(); pv_tile<BF>(o, vb0, pa0, pa1, pa2, pa3); } \
        if (more_) { AWAITV(); } \
        __syncthreads(); } while (0)
#define APK4(P, B_, OUT) do { unsigned a0 = cvtpk(P[B_+0], P[B_+1]), a1 = cvtpk(P[B_+2], P[B_+3]); \
        unsigned b0 = cvtpk(P[B_+4], P[B_+5]), b1 = cvtpk(P[B_+6], P[B_+7]); \
        auto r0 = __builtin_amdgcn_permlane32_swap(a0, b0, false, false); auto r1 = __builtin_amdgcn_permlane32_swap(a1, b1, false, false); \
        u32x4 w = {r0[0], r1[0], r0[1], r1[1]}; OUT = __builtin_bit_cast(bf16x8, w); } while (0)
    for (int j = 0; j < u.nt; j += 2) {
        ASTEP(0, j);
        if (j + 1 < u.nt) ASTEP(1, j + 1);
    }
    if (wact) {
        if (hi == 0) li_l[r32] = l_reg;
        asm volatile("s_waitcnt lgkmcnt(0)" ::: "memory");
        float rli[16];
#pragma unroll
        for (int r = 0; r < 16; ++r) rli[r] = __builtin_amdgcn_rcpf(li_l[crow(r, hi)]);
        bf16_t* Ow = u.O + (size_t)(wid * 32) * DM;
        const bool ev = (r32 & 1) == 0;
        unsigned gg[16][4];
        if (ev) {
#pragma unroll
            for (int r = 0; r < 16; ++r)
#pragma unroll
                for (int d0 = 0; d0 < 4; ++d0) gg[r][d0] = *(const unsigned*)(Ow + (size_t)crow(r, hi) * DM + d0 * 32 + r32);
        }
#pragma unroll
        for (int r = 0; r < 16; ++r) { const int orow = crow(r, hi);
#pragma unroll
            for (int d0 = 0; d0 < 4; ++d0) { const float v = o[d0][r] * rli[r]; const float vn = __shfl_xor(v, 1);
                if (ev) { unsigned* p = (unsigned*)(Ow + (size_t)orow * DM + d0 * 32 + r32); const unsigned g = gg[r][d0]; *p = cvtpk(v * bflo(g), vn * bfhi(g)); } } }
    }
#undef ADMA
#undef AWAITV
#undef ASTEP
#undef APK4
}
#undef SBAR
}


namespace chk {
constexpr int CHKB = 15360;
constexpr int O_GA = 0, O_RA = 8192, O_HA = 10240, O_MA = 12288, O_VB = 12800, O_P = 14848;
typedef __bf16 cbf16x2 __attribute__((ext_vector_type(2)));
__device__ __forceinline__ unsigned cpk(float lo, float hi) { const f32x2 v = {lo, hi}; const cbf16x2 b = __builtin_convertvector(v, cbf16x2); return __builtin_bit_cast(unsigned, b); }
__device__ __forceinline__ bf16_t cbf(float f) { return (bf16_t)(cpk(f, 0.f) & 0xffffu); }
__device__ __forceinline__ u32x4 cpack8(const float* f) { u32x4 w; w.x = cpk(f[0], f[1]); w.y = cpk(f[2], f[3]); w.z = cpk(f[4], f[5]); w.w = cpk(f[6], f[7]); return w; }
__device__ __forceinline__ s16x4 pack4(const f32x4& a) { u32x2 w; w.x = cpk(a.x, a.y); w.y = cpk(a.z, a.w); return __builtin_bit_cast(s16x4, w); }
__device__ __forceinline__ bf16x8 pack8(const f32x4& a, const f32x4& b) { u32x4 w; w.x = cpk(a.x, a.y); w.y = cpk(a.z, a.w); w.z = cpk(b.x, b.y); w.w = cpk(b.z, b.w); return __builtin_bit_cast(bf16x8, w); }
__device__ __forceinline__ f32x4 mm32(bf16x8 a, bf16x8 b, f32x4 c) { f32x4 d = __builtin_amdgcn_mfma_f32_16x16x32_bf16(a, b, c, 0, 0, 0); asm volatile("" : "+v"(d) : "v"(a), "v"(b)); return d; }
__device__ __forceinline__ f32x4 mm16(s16x4 a, s16x4 b, f32x4 c) { f32x4 d = __builtin_amdgcn_mfma_f32_16x16x16bf16_1k(a, b, c, 0, 0, 0); asm volatile("" : "+v"(d) : "v"(a), "v"(b)); return d; }
#define CHK_LW() asm volatile("s_waitcnt lgkmcnt(0)" ::: "memory")

struct Raw { float w[16], kk[16], b[16], r[16], k[16], v[16]; };
__device__ __forceinline__ void raw_load(Raw& x, const char* rec, int lane) {
    const int fr = lane & 15, fq = lane >> 4;
#pragma unroll
    for (int t = 0; t < 16; ++t) {
        const float* rp = (const float*)(rec + (size_t)t * REC) + lane; const bf16_t* hp = (const bf16_t*)(rec + (size_t)t * REC + 768) + lane;
        x.w[t] = rp[0]; x.kk[t] = rp[64]; x.b[t] = rp[128]; x.r[t] = bf2f(hp[0]); x.k[t] = bf2f(hp[64]);
    }
#pragma unroll
    for (int vt = 0; vt < 4; ++vt)
#pragma unroll
        for (int e = 0; e < 4; ++e) x.v[vt * 4 + e] = bf2f(*(const bf16_t*)(rec + (size_t)(4 * fq + e) * REC + 1024 + (16 * vt + fr) * 2));
}
__device__ __forceinline__ void precompute(const char* rec, char* out, LAS char* wl, int lane) {
    const int fr = lane & 15, fq = lane >> 4;
    Raw x; raw_load(x, rec, lane);
    const f32x4 zero4 = (f32x4){0.f, 0.f, 0.f, 0.f};
    float At[16], Rt[16], Bt[16], Kt[16];
    float P = 1.f;
#pragma unroll
    for (int t = 0; t < 16; ++t) {
        const float Pm1 = P; P *= x.w[t]; const float ip = __builtin_amdgcn_rcpf(P);
        At[t] = -x.kk[t] * Pm1; Rt[t] = x.r[t] * P; Bt[t] = x.b[t] * ip; Kt[t] = x.k[t] * ip;
    }
    const float P15 = P;
#pragma unroll
    for (int vt = 0; vt < 4; ++vt) *(s16x4*)(out + O_VB + vt * 512 + lane * 8) = pack4((f32x4){x.v[vt * 4 + 0], x.v[vt * 4 + 1], x.v[vt * 4 + 2], x.v[vt * 4 + 3]});
    *(float*)(out + O_P + lane * 4) = P15;
    {
        LAS bf16_t* X = (LAS bf16_t*)wl;
#pragma unroll
        for (int t = 0; t < 16; ++t) {
            const int idx = t * 64 + ((((lane >> 3) ^ ((t >> 1) & 7))) << 3) + (lane & 7);
            const bf16_t bh = cbf(Bt[t]), ah = cbf(At[t]);
            X[idx] = bh; X[1024 + idx] = cbf(Bt[t] - bf2f(bh)); X[2048 + idx] = ah; X[3072 + idx] = cbf(At[t] - bf2f(ah)); X[4096 + idx] = cbf(Kt[t]); X[5120 + idx] = cbf(Rt[t]);
        }
        float bc[16];
#pragma unroll
        for (int t = 0; t < 16; ++t) bc[t] = Bt[t] * P15;
        LAS u32x4* at_t = (LAS u32x4*)(wl + 12288 + lane * 32); LAS u32x4* bc_t = (LAS u32x4*)(wl + 14336 + lane * 32);
        at_t[0] = cpack8(At); at_t[1] = cpack8(At + 8); bc_t[0] = cpack8(bc); bc_t[1] = cpack8(bc + 8);
    }
    CHK_LW();
    f32x4 Nc = zero4, Makc = zero4, Mrbc = zero4, Mrkc = zero4;
    {
#pragma unroll
        for (int s2 = 0; s2 < 2; ++s2) {
            const int off = fr * 128 + (((fq + 4 * s2) ^ ((fr >> 1) & 7)) << 4);
            const bf16x8 bh = *(LAS const bf16x8*)(wl + off), bl = *(LAS const bf16x8*)(wl + 2048 + off), ah = *(LAS const bf16x8*)(wl + 4096 + off), al = *(LAS const bf16x8*)(wl + 6144 + off);
            const bf16x8 kh = *(LAS const bf16x8*)(wl + 8192 + off), rh = *(LAS const bf16x8*)(wl + 10240 + off);
            Nc = mm32(bh, ah, Nc); Nc = mm32(bh, al, Nc); Nc = mm32(bl, ah, Nc);
            Makc = mm32(kh, ah, Makc); Mrbc = mm32(bh, rh, Mrbc); Mrkc = mm32(kh, rh, Mrkc);
        }
#pragma unroll
        for (int j = 0; j < 4; ++j) { const int i = 4 * fq + j; if (!(i < fr)) { Nc[j] = 0.f; Makc[j] = 0.f; } if (!(i <= fr)) { Mrbc[j] = 0.f; Mrkc[j] = 0.f; } }
    }
    CHK_LW();
    {
        LAS float* NS = (LAS float*)wl; LAS bf16_t* MAK = (LAS bf16_t*)(wl + 1536);
#pragma unroll
        for (int j = 0; j < 4; ++j) { NS[(4 * fq + j) * 16 + fr] = Nc[j]; MAK[(4 * fq + j) * 16 + fr] = cbf(Makc[j]); }
        CHK_LW();
        float T[16];
#pragma unroll
        for (int i = 15; i >= 0; --i) {
            float acc = 0.f;
#pragma unroll
            for (int q4 = (i + 1) / 4; q4 < 4; ++q4) { const f32x4 nv = *(LAS const f32x4*)(NS + i * 16 + q4 * 4);
#pragma unroll
                for (int e = 0; e < 4; ++e) { const int jj = q4 * 4 + e; if (jj > i) acc += nv[e] * T[jj]; } }
            T[i] = (i == fr) ? 1.f : ((i < fr) ? acc : 0.f);
        }
        LAS u32x4* tt = (LAS u32x4*)(wl + 1024 + fr * 32);
        tt[0] = cpack8(T); tt[1] = cpack8(T + 8);
    }
    CHK_LW();
#define CHK_A16(base, rowb) (*(LAS const s16x4*)(wl + (base) + ((rowb) + fr) * 32 + fq * 8))
    const s16x4 TTf = CHK_A16(1024, 0);
    {
        LAS bf16_t* AH = (LAS bf16_t*)(wl + 2560); LAS bf16_t* MAKP = (LAS bf16_t*)(wl + 2048);
        f32x4 ahc[4];
#pragma unroll
        for (int mk = 0; mk < 4; ++mk) ahc[mk] = mm16(CHK_A16(12288, 16 * mk), TTf, zero4);
        const f32x4 makp = mm16(CHK_A16(1536, 0), TTf, zero4);
#pragma unroll
        for (int mk = 0; mk < 4; ++mk)
#pragma unroll
            for (int j = 0; j < 4; ++j) AH[(16 * mk + 4 * fq + j) * 16 + fr] = cbf(ahc[mk][j]);
#pragma unroll
        for (int j = 0; j < 4; ++j) MAKP[(4 * fq + j) * 16 + fr] = cbf(makp[j]);
        float kc[16];
#pragma unroll
        for (int t = 0; t < 16; ++t) kc[t] = Kt[t] * P15;
        LAS u32x4* rt_t = (LAS u32x4*)(wl + 4608 + lane * 32); LAS u32x4* kc_t = (LAS u32x4*)(wl + 6656 + lane * 32);
        rt_t[0] = cpack8(Rt); rt_t[1] = cpack8(Rt + 8); kc_t[0] = cpack8(kc); kc_t[1] = cpack8(kc + 8);
    }
    CHK_LW();
    const s16x4 Mrb_b = pack4(Mrbc);
    s16x4 Ident;
#pragma unroll
    for (int e = 0; e < 4; ++e) Ident[e] = (4 * fq + e == fr) ? (short)0x3F80 : (short)0;
    {
        f32x4 rh[4];
#pragma unroll
        for (int mk = 0; mk < 4; ++mk) { f32x4 d = mm16(CHK_A16(2560, 16 * mk), Mrb_b, zero4); rh[mk] = mm16(CHK_A16(4608, 16 * mk), Ident, d); }
        *(bf16x8*)(out + O_RA + lane * 16) = pack8(rh[0], rh[1]);
        *(bf16x8*)(out + O_RA + 1024 + lane * 16) = pack8(rh[2], rh[3]);
    }
    { const f32x4 mo = mm16(CHK_A16(2048, 0), Mrb_b, Mrkc); *(s16x4*)(out + O_MA + lane * 8) = pack4(mo); }
#pragma unroll
    for (int nk = 0; nk < 4; ++nk) {
        const s16x4 bcf = CHK_A16(14336, 16 * nk);
        f32x4 gc[4];
#pragma unroll
        for (int mk = 0; mk < 4; ++mk) gc[mk] = mm16(CHK_A16(2560, 16 * mk), bcf, zero4);
        *(bf16x8*)(out + O_GA + (nk * 2 + 0) * 1024 + lane * 16) = pack8(gc[0], gc[1]);
        *(bf16x8*)(out + O_GA + (nk * 2 + 1) * 1024 + lane * 16) = pack8(gc[2], gc[3]);
        f32x4 hc = mm16(CHK_A16(2048, 0), bcf, zero4); hc = mm16(Ident, CHK_A16(6656, 16 * nk), hc);
        *(s16x4*)(out + O_HA + nk * 512 + lane * 8) = pack4(hc);
    }
    CHK_LW();
#undef CHK_A16
}

struct Ops { bf16x8 ga[4][2]; bf16x8 ra[2]; s16x4 ha[4]; s16x4 ma, vb; f32x4 p[4]; };
__device__ __forceinline__ void load_ops(Ops& o, const char* c, int vt, int lane) {
    const int fq = lane >> 4;
#pragma unroll
    for (int mt = 0; mt < 4; ++mt) {
#pragma unroll
        for (int s2 = 0; s2 < 2; ++s2) o.ga[mt][s2] = *(const bf16x8*)(c + O_GA + (mt * 2 + s2) * 1024 + lane * 16);
        o.ha[mt] = *(const s16x4*)(c + O_HA + mt * 512 + lane * 8);
        o.p[mt] = *(const f32x4*)(c + O_P + (16 * mt + 4 * fq) * 4);
    }
    o.ra[0] = *(const bf16x8*)(c + O_RA + lane * 16); o.ra[1] = *(const bf16x8*)(c + O_RA + 1024 + lane * 16);
    o.ma = *(const s16x4*)(c + O_MA + lane * 8); o.vb = *(const s16x4*)(c + O_VB + vt * 512 + lane * 8);
}
__device__ __forceinline__ void step(f32x4 (&Z)[4], const Ops& o, float* orow  , int fq) {
    const bf16x8 bz0 = pack8(Z[0], Z[1]), bz1 = pack8(Z[2], Z[3]);
    f32x4 ot = mm32(o.ra[0], bz0, (f32x4){0.f, 0.f, 0.f, 0.f});
    f32x4 zn[4];
#pragma unroll
    for (int mt = 0; mt < 4; ++mt) zn[mt] = mm32(o.ga[mt][0], bz0, o.p[mt] * Z[mt]);
    ot = mm32(o.ra[1], bz1, ot);
#pragma unroll
    for (int mt = 0; mt < 4; ++mt) zn[mt] = mm32(o.ga[mt][1], bz1, zn[mt]);
    ot = mm16(o.ma, o.vb, ot);
#pragma unroll
    for (int mt = 0; mt < 4; ++mt) Z[mt] = mm16(o.ha[mt], o.vb, zn[mt]);
#pragma unroll
    for (int j = 0; j < 4; ++j) orow[(size_t)(4 * fq + j) * RW] = ot[j];
    asm volatile("" :: "v"(o.ga[0][0]), "v"(o.ga[0][1]), "v"(o.ga[1][0]), "v"(o.ga[1][1]), "v"(o.ga[2][0]), "v"(o.ga[2][1]), "v"(o.ga[3][0]), "v"(o.ga[3][1]),
                 "v"(o.ra[0]), "v"(o.ra[1]), "v"(o.ha[0]), "v"(o.ha[1]), "v"(o.ha[2]), "v"(o.ha[3]), "v"(o.ma), "v"(o.vb), "v"(bz0), "v"(bz1));
}
constexpr int RING_SLOTS = 7, SLOT_B = 16384, AHEAD = 6;
__device__ __forceinline__ void lds_ops(Ops& o, LAS const char* c, int vt, int lane) {
    const int fq = lane >> 4;
#pragma unroll
    for (int mt = 0; mt < 4; ++mt) {
#pragma unroll
        for (int s2 = 0; s2 < 2; ++s2) o.ga[mt][s2] = *(LAS const bf16x8*)(c + O_GA + (mt * 2 + s2) * 1024 + lane * 16);
        o.ha[mt] = *(LAS const s16x4*)(c + O_HA + mt * 512 + lane * 8);
        o.p[mt] = *(LAS const f32x4*)(c + O_P + (16 * mt + 4 * fq) * 4);
    }
    o.ra[0] = *(LAS const bf16x8*)(c + O_RA + lane * 16); o.ra[1] = *(LAS const bf16x8*)(c + O_RA + 1024 + lane * 16);
    o.ma = *(LAS const s16x4*)(c + O_MA + lane * 8); o.vb = *(LAS const s16x4*)(c + O_VB + vt * 512 + lane * 8);
}
__device__ __forceinline__ void seq_wg(const char* c0, int nch, const float* S0, float* o_out, float* s_out, LAS char* lds, int wave, int lane) {
    const int fr = lane & 15, fq = lane >> 4;
#define RAWBAR() do { asm volatile("" ::: "memory"); __builtin_amdgcn_s_barrier(); asm volatile("" ::: "memory"); } while (0)
    if (wave >= 4) {
        const int pw = (wave - 4) * 4;
        const char* src0 = c0 + (size_t)pw * 1024 + lane * 16;
#define FEED(ci, slot) do { const int ci_ = (ci) < nch ? (ci) : nch - 1; const char* s_ = src0 + (size_t)ci_ * CHKB; LAS char* d_ = lds + (slot) * SLOT_B + pw * 1024; \
            _Pragma("unroll") for (int q = 0; q < 4; ++q) __builtin_amdgcn_global_load_lds((const unsigned*)(s_ + q * 1024), (LAS unsigned*)(d_ + q * 1024), 16, 0, 0); } while (0)
#pragma unroll
        for (int i = 0; i < AHEAD; ++i) FEED(i, i);
        asm volatile("s_waitcnt vmcnt(20)" ::: "memory");
        RAWBAR();
        int slot = AHEAD;
        for (int c = 0; c < nch; ++c) {
            FEED(c + AHEAD, slot); slot = (slot == RING_SLOTS - 1) ? 0 : slot + 1;
            asm volatile("s_waitcnt vmcnt(20)" ::: "memory");
            RAWBAR();
        }
        asm volatile("s_waitcnt vmcnt(0)" ::: "memory");
        RAWBAR();
#undef FEED
    } else {
        const int vt = wave;
        f32x4 Z[4];
#pragma unroll
        for (int mt = 0; mt < 4; ++mt) Z[mt] = S0 ? *(const f32x4*)(S0 + (16 * vt + fr) * 64 + 16 * mt + 4 * fq) : (f32x4){0.f, 0.f, 0.f, 0.f};
        float* ocol = o_out + 16 * vt + fr;
        Ops A, B;
        RAWBAR();
        lds_ops(A, lds, vt, lane);
        int slot = 1;
#pragma unroll 1
        for (int c = 0; c < nch; c += 2) {
            asm volatile("s_waitcnt lgkmcnt(0)" ::: "memory");
            RAWBAR();
            lds_ops(B, lds + slot * SLOT_B, vt, lane); slot = (slot == RING_SLOTS - 1) ? 0 : slot + 1;
            step(Z, A, ocol + (size_t)(16 * c) * RW, fq);
            asm volatile("s_waitcnt lgkmcnt(0)" ::: "memory");
            RAWBAR();
            lds_ops(A, lds + slot * SLOT_B, vt, lane); slot = (slot == RING_SLOTS - 1) ? 0 : slot + 1;
            step(Z, B, ocol + (size_t)(16 * (c + 1)) * RW, fq);
        }
#pragma unroll
        for (int mt = 0; mt < 4; ++mt) *(f32x4*)(s_out + (16 * vt + fr) * 64 + 16 * mt + 4 * fq) = Z[mt];
        asm volatile("s_waitcnt lgkmcnt(0)" : "+v"(A.ga[0][0]), "+v"(A.ra[0]) :: "memory");
        RAWBAR();
    }
#undef RAWBAR
}
#undef CHK_LW
}

constexpr int RING_BYTES = 131072;
constexpr int LDSCTL_OFF = RING_BYTES, MISC_OFF = LDSCTL_OFF + 320, XL_OFF = LDSCTL_OFF + 1024;
constexpr int LDS_BYTES = 147456;
static_assert(att::LDS_BYTES <= RING_BYTES && pg8::STAGE_BYTES <= RING_BYTES && XL_OFF + 8192 <= LDS_BYTES, "LDS map");
constexpr int NWAVES = 8, NPHASE = 16;

struct Args { const float* in[35]; float* out; unsigned char* ws; int ph_lo, ph_hi, li, pad; };

__device__ __forceinline__ void transpose_item(const float* W, int K, int N, bf16_t* WT, int row_off, LAS float* scr, int item, int lane) {
    const int nblk = N / 32, kb = item / nblk, nb = item % nblk, k0 = 64 * kb, n0 = 32 * nb;
    float tv[32];
    const float* wsrc = W + (size_t)(k0 + (lane >> 5)) * N + n0 + (lane & 31);
#pragma unroll
    for (int i = 0; i < 32; ++i) tv[i] = wsrc[(size_t)(2 * i) * N];
#pragma unroll
    for (int i = 0; i < 32; ++i) scr[(2 * i + (lane >> 5)) * 33 + (lane & 31)] = tv[i];
    asm volatile("s_waitcnt lgkmcnt(0)" ::: "memory");
    const int c = lane & 7;
#pragma unroll
    for (int j = 0; j < 4; ++j) { const int n = (lane >> 3) + 8 * j; const LAS float* s = scr + (8 * c) * 33 + n;
        u32x4 o; o.x = cvtpk(s[0 * 33], s[1 * 33]); o.y = cvtpk(s[2 * 33], s[3 * 33]); o.z = cvtpk(s[4 * 33], s[5 * 33]); o.w = cvtpk(s[6 * 33], s[7 * 33]);
        *(u32x4*)(WT + (size_t)(row_off + n0 + n) * K + k0 + 8 * c) = o; }
    asm volatile("s_waitcnt lgkmcnt(0)" ::: "memory");
}
__device__ __forceinline__ void convert_weights(const Args& a, int l, LAS unsigned char* lds, int gw, int ngw, int wave, int lane, int which, unsigned* ticket) {
    unsigned char* ws = a.ws;
    bf16_t* wtin = (bf16_t*)(ws + WS_WTIN); bf16_t* wtout = (bf16_t*)(ws + WS_WTOUT); bf16_t* wtuq = (bf16_t*)(ws + WS_WTUQ); bf16_t* wtukv = (bf16_t*)(ws + WS_WTUKV);
    const float* w_in = a.in[12] + (size_t)l * DM * IN_COLS; const float* w_out = a.in[34] + (size_t)l * DM * DM;
    const float* w_uq = a.in[25] + (size_t)l * QL * QW; const float* w_uk = a.in[26] + (size_t)l * KVL * MLAD; const float* w_uv = a.in[27] + (size_t)l * KVL * MLAD;
    LAS float* scr = (LAS float*)(lds + wave * 16384);
    constexpr int I_IN = (DM / 64) * (IN_COLS / 32), I_OUT = (DM / 64) * (DM / 32), I_UQ = (QL / 64) * (QW / 32), I_UK = (KVL / 64) * (MLAD / 32);
    const int n_in = (which & 1) ? I_IN : 0, n_out = (which & 2) ? I_OUT : 0, n_uq = (which & 4) ? I_UQ : 0, n_uk = (which & 4) ? I_UK : 0;
    const int NITEMS = n_in + n_out + n_uq + 2 * n_uk;
    int it = gw, left = 0;
    for (;; ) {
        if (ticket) {
            if (left == 0) { unsigned tk = 0; if (lane == 0) tk = __hip_atomic_fetch_add(ticket, 8u, __ATOMIC_RELAXED, __HIP_MEMORY_SCOPE_AGENT); it = (int)__builtin_amdgcn_readfirstlane(tk); left = 8; }
            else ++it;
            --left;
        }
        if (it >= NITEMS) break;
        int r = it;
        if (!ticket) it += ngw;
        if (r < n_in) { transpose_item(w_in, DM, IN_COLS, wtin, 0, scr, r, lane); continue; } r -= n_in;
        if (r < n_out) { transpose_item(w_out, DM, DM, wtout, 0, scr, r, lane); continue; } r -= n_out;
        if (r < n_uq) { transpose_item(w_uq, QL, QW, wtuq, 0, scr, r, lane); continue; } r -= n_uq;
        if (r < n_uk) { transpose_item(w_uk, KVL, MLAD, wtukv, 0, scr, r, lane); continue; } r -= n_uk;
        transpose_item(w_uv, KVL, MLAD, wtukv, MLAD, scr, r, lane);
    }
    if (which & 1) { unsigned zz; asm volatile("v_mov_b32 %0, 0" : "=v"(zz));
        for (int p = gw * 64 + lane; p < 64 * DM / 8; p += ngw * 64) *(u32x4*)(wtin + (size_t)IN_COLS * DM + (size_t)p * 8) = (u32x4){zz, zz, zz, zz}; }
}

#define PHASE_LOCALS \
    int t__ = threadIdx.x; asm volatile("" : "+v"(t__)); \
    unsigned long long z__ = 0; asm volatile("" : "+s"(z__)); \
    unsigned char* ws = args.ws + z__; float* out = args.out + z__; \
    int g__ = (int)gridDim.x, b__ = (int)blockIdx.x; asm volatile("" : "+s"(g__), "+s"(b__)); const int G = g__, bx = b__;     \
    const int tid = t__, lane = tid & 63, wave = __builtin_amdgcn_readfirstlane(tid >> 6); \
    const int gw = bx * NWAVES + wave, ngw = G * NWAVES; \
    float2* tab = (float2*)(ws + WS_TAB); float* modp = (float*)(ws + WS_MODP); float* modf = (float*)(ws + WS_MODF); float* rkdot = (float*)(ws + WS_RKDOT); \
    bf16_t* wtin = (bf16_t*)(ws + WS_WTIN); bf16_t* wtout = (bf16_t*)(ws + WS_WTOUT); bf16_t* wtuq = (bf16_t*)(ws + WS_WTUQ); bf16_t* wtukv = (bf16_t*)(ws + WS_WTUKV); \
    bf16_t* hmix = (bf16_t*)(ws + WS_HMIX); bf16_t* proj = (bf16_t*)(ws + WS_PROJ); bf16_t* Kn = (bf16_t*)(ws + WS_KN); bf16_t* Vb = (bf16_t*)(ws + WS_V); \
    char* scanrec = (char*)(ws + WS_SCAN); bf16_t* Qb = (bf16_t*)(ws + WS_Q); bf16_t* latall = (bf16_t*)(ws + WS_LAT); bf16_t* Krb = (bf16_t*)(ws + WS_KR); \
    float* obuf = (float*)(ws + WS_OBUF); bf16_t* qin = (bf16_t*)(ws + WS_QIN); \
    const float* xp = l == 0 ? args.in[0] : out + O_YP; const float* xs = l == 0 ? args.in[1] : out + O_YS; \
    const float* modf_l = modf + (size_t)l * 20 * 3 * DM; \
    (void)tid; (void)lane; (void)wave; (void)gw; (void)ngw; (void)tab; (void)modp; (void)modf; (void)rkdot; (void)wtin; (void)wtout; (void)wtuq; (void)wtukv; (void)hmix; (void)proj; (void)Kn; (void)Vb; \
    (void)scanrec; (void)Qb; (void)latall; (void)Krb; (void)obuf; (void)qin; (void)xp; (void)xs; (void)modf_l;
__global__ void __launch_bounds__(NWAVES * 64, 2) mk_fwd(Args args) {
    extern __shared__ __attribute__((aligned(16))) unsigned char lds_raw[];
    LAS unsigned char* lds = (LAS unsigned char*)lds_raw;
    volatile LAS unsigned* MISC = (volatile LAS unsigned*)(lds + MISC_OFF);
    const int G = gridDim.x, bx = blockIdx.x;
    unsigned* ctl = (unsigned*)(args.ws + WS_CTL);
    for (int u = threadIdx.x; u < (LDS_BYTES - LDSCTL_OFF) / 4; u += NWAVES * 64) ((LAS unsigned*)(lds + LDSCTL_OFF))[u] = 0u;
    __syncthreads();
    XcdBarrier bar = xcd_barrier_post(ctl + CW_BAR + args.li * XCD_BAR_WORDS, MISC + 8);
    const int lo = args.ph_lo, hi = args.ph_hi;
#define IN(k) (lo <= (k) && (k) < hi)
#define SEAM(k) do { if (IN(k) && IN((k) + 1)) xcd_barrier(bar); } while (0)

    if (IN(0) && EN(0)) {
        const int l = 0; PHASE_LOCALS
        for (int i = bx * 512 + tid; i < 4096 * 32; i += G * 512) {
            const int pos = i >> 5, fi = i & 31;
            const float ang = (float)pos * ROPE_FREQ[fi];
            double rev = (double)ang * 0.15915494309189535; rev -= __builtin_rint(rev);
            const float fr = (float)rev;
            tab[i] = make_float2(__builtin_amdgcn_cosf(fr), __builtin_amdgcn_sinf(fr));
        }
        {
            LAS float* cs = (LAS float*)lds;
            for (int w0 = bx; w0 < 256; w0 += G) {
                const int p = w0 % 24, sl = w0 / 24, np = p < 16 ? 11 : 10;
                const int lm = p / 12, cg = p % 12, col = cg * 1024 + tid * 2;
                f32x2 acc[20];
#pragma unroll
                for (int r2 = 0; r2 < 20; ++r2) acc[r2] = (f32x2){0.f, 0.f};
                for (int ch = sl; ch < 32; ch += np) {
                    const int k0 = ch * 128;
                    __syncthreads();
                    for (int e = tid; e < 20 * 128; e += 512) { const int row = e >> 7, k = e & 127;
                        cs[e] = row < 4 ? args.in[2][(size_t)row * DM + k0 + k] : args.in[3][(size_t)(row - 4) * DM + k0 + k]; }
                    __syncthreads();
                    const float* wp = args.in[9] + ((size_t)lm * DM + k0) * (3 * DM) + col;
#pragma unroll 2
                    for (int k = 0; k < 128; k += 4) {
                        const f32x2 wa = *(const f32x2*)(wp + (size_t)(k + 0) * (3 * DM)), wb = *(const f32x2*)(wp + (size_t)(k + 1) * (3 * DM));
                        const f32x2 wc = *(const f32x2*)(wp + (size_t)(k + 2) * (3 * DM)), wd = *(const f32x2*)(wp + (size_t)(k + 3) * (3 * DM));
#pragma unroll
                        for (int r2 = 0; r2 < 20; ++r2) { const f32x4 cv = *(LAS const f32x4*)(cs + r2 * 128 + k);
                            acc[r2] = wa * cv.x + acc[r2]; acc[r2] = wb * cv.y + acc[r2]; acc[r2] = wc * cv.z + acc[r2]; acc[r2] = wd * cv.w + acc[r2]; }
                    }
                }
                float* mp = modp + ((size_t)(lm * 11 + sl) * 20) * (3 * DM) + col;
#pragma unroll
                for (int r2 = 0; r2 < 20; ++r2) *(f32x2*)(mp + (size_t)r2 * (3 * DM)) = acc[r2];
            }
            __syncthreads();
        }
        {
            unsigned* w2p = (unsigned*)(ws + WS_W2P);
            for (int i = bx * 512 + tid; i < 2 * 2 * 32 * RW; i += G * 512) {
                const int c = i & 1023, ip = (i >> 10) & 31, mat = (i >> 15) & 1, lw_ = i >> 16;
                const float* src = (mat ? args.in[17] : args.in[15]) + (size_t)lw_ * 64 * RW;
                w2p[i] = cvtpk(src[(size_t)(2 * ip) * RW + c], src[(size_t)(2 * ip + 1) * RW + c]);
            }
        }
        convert_weights(args, 0, lds, gw, ngw, wave, lane, 7, nullptr);
    }
    SEAM(0);
    if (IN(1) && EN(1)) {
        const int l = 0; PHASE_LOCALS
        for (int i = bx * 512 + tid; i < 2 * 20 * DM; i += G * 512) {
            const int lf = i / (20 * DM), r = i % (20 * DM), seq = r / DM, col = r % DM;
            float sh = args.in[10][(size_t)lf * 3 * DM + col], sc = args.in[10][(size_t)lf * 3 * DM + DM + col], gt = args.in[10][(size_t)lf * 3 * DM + 2 * DM + col];
            for (int which = 0; which < 3; ++which) {
                const int c3 = which * DM + col, p = lf * 12 + (c3 >> 10);
                const int np = p < 16 ? 11 : 10;
                float a = 0.f;
                for (int sl = 0; sl < np; ++sl) a += modp[((size_t)(lf * 11 + sl) * 20 + seq) * (3 * DM) + c3];
                if (which == 0) sh += a; else if (which == 1) sc += a; else gt += a; }
            float* mf = modf + ((size_t)(lf * 20 + seq) * 3) * DM;
            mf[col] = args.in[11][(size_t)lf * DM + col] * (1.f + sc); mf[DM + col] = sh; mf[2 * DM + col] = gt;
        }
    }
    SEAM(1);

    for (int l = 0; l < DEPTH; ++l) {
        const int pb = 2 + 7 * l;
        if (IN(pb + 0) && EN(2)) {
            const bool splitA = (G == 256);
#define NORM_ROW(m) do { \
                const float* xr = (m) < MP ? xp + (size_t)(m) * DM : xs + (size_t)((m) - MP) * DM; \
                const int seq = (m) < MP ? ((m) >> 12) : 4 + (((m) - MP) >> 5); \
                const f32x4* x4 = (const f32x4*)xr + lane; \
                f32x4 v[16]; float ss = 0.f; \
                _Pragma("unroll") for (int j = 0; j < 16; ++j) { v[j] = x4[64 * j]; ss += (v[j].x * v[j].x + v[j].y * v[j].y) + (v[j].z * v[j].z + v[j].w * v[j].w); } \
                const float rstd = rsqrtf(wave_sum(ss) * (1.f / DM) + NORM_EPS); \
                const f32x4* A4 = (const f32x4*)(modf_l + (size_t)(seq * 3 + 0) * DM) + lane; \
                const f32x4* B4 = (const f32x4*)(modf_l + (size_t)(seq * 3 + 1) * DM) + lane; \
                u32x2* o8 = (u32x2*)(hmix + (size_t)(m) * DM) + lane; \
                _Pragma("unroll") for (int j = 0; j < 16; ++j) { const f32x4 av = A4[64 * j], bv = B4[64 * j]; const f32x4 y = v[j] * rstd * av + bv; \
                    u32x2 w; w.x = cvtpk(y.x, y.y); w.y = cvtpk(y.z, y.w); o8[64 * j] = w; } } while (0)
            {
                PHASE_LOCALS
                if (splitA) { for (int m = MP + gw; m < M; m += ngw) NORM_ROW(m); }
            }
            if (splitA) xcd_barrier(bar);
            {
                PHASE_LOCALS
                if (splitA && bx < 94) {
                    pg8::Gemm g{hmix + (size_t)MP * DM, wtin, MS, NPAD, DM}; pg8::StaticOrder S; S.init(MS, NPAD, 94, bx);
                    pg8::EpiBf16 E{proj + (size_t)MP * NPAD, NPAD, 0, 0};
                    pg8::gemm_phase<pg8::EpiBf16, pg8::StaticOrder, true, true>(lds, g, S, E);
                } else {
                    const int nw0 = splitA ? (bx - 94) * NWAVES + wave : gw, nnw = splitA ? (G - 94) * NWAVES : ngw;
                    if (l > 0) convert_weights(args, l, lds, nw0, nnw, wave, lane, 2, nullptr);
                    for (int m = nw0; m < (splitA ? MP : M); m += nnw) NORM_ROW(m);
                }
            }
#undef NORM_ROW
        }
        SEAM(pb + 0);
        if (IN(pb + 1) && EN(3)) {
            PHASE_LOCALS
            const int MB = (G == 256) ? MP : M;
            pg8::Gemm g{hmix, wtin, MB, NPAD, DM}; pg8::StaticOrder S; S.init(MB, NPAD, G, bx);
            pg8::EpiBf16 E{proj, NPAD, 0, 0};
            pg8::gemm_phase<pg8::EpiBf16, pg8::StaticOrder, true, true>(lds, g, S, E);
        }
        SEAM(pb + 1);
        if (IN(pb + 2) && EN(4)) {
            PHASE_LOCALS
            {
                LAS unsigned* actP = (LAS unsigned*)lds;
                const unsigned* w2pl = (const unsigned*)(ws + WS_W2P) + (size_t)l * 2 * 32 * RW;
                const float* mu = args.in[13] + (size_t)l * SHIFT_DIM;
                const float* w0p = args.in[14] + (size_t)l * RW; const float* w2p = args.in[15] + (size_t)l * 64 * RW;
                const float* a0p = args.in[16] + (size_t)l * RW; const float* a2p = args.in[17] + (size_t)l * 64 * RW;
                const float* kkp = args.in[18] + (size_t)l * RW; const float* kap = args.in[19] + (size_t)l * RW; const float* rkp = args.in[20] + (size_t)l * RW;
                const int h = tid >> 5, kp = tid & 31, c0 = 2 * tid;
                const f32x2 mu_r = *(const f32x2*)(mu + c0), mu_k = *(const f32x2*)(mu + RW + c0), mu_v = *(const f32x2*)(mu + 2 * RW + c0);
                const f32x2 w0v = *(const f32x2*)(w0p + c0), a0v = *(const f32x2*)(a0p + c0), kkw = *(const f32x2*)(kkp + c0), kaw = *(const f32x2*)(kap + c0), rkw = *(const f32x2*)(rkp + c0);
                for (int tile = bx; tile < M / 16; tile += G) {
                    const int m0 = tile * 16;
                    const bool smp = m0 >= MP;
                    const int b = smp ? ((m0 - MP) >> 5) : (m0 >> 12), t0 = smp ? ((m0 - MP) & 31) : (m0 & 4095);
                    const bool first = t0 == 0;
                    const float* shst = args.in[7] + (size_t)(l * DB + b) * SHIFT_DIM;
                    const size_t rec0 = smp ? (size_t)SREC_S0 + (size_t)(b * 16 + h) * DS + t0 : (size_t)(b * 16 + h) * SEQ + t0;
                    __syncthreads();
#pragma unroll
                    for (int e = 0; e < 4; ++e) { const int idx = tid + 512 * e, tok = idx >> 7, i = idx & 127, col = 3072 + i, m = m0 + tok;
                        const float cur = bf2f(proj[(size_t)m * NPAD + col]);
                        float prev;
                        if (tok == 0 && first) prev = smp ? shst[col] : 0.f; else prev = bf2f(proj[(size_t)(m - 1) * NPAD + col]);
                        float xsv = cur + (prev - cur) * mu[col];
                        if (i < 64) { const float e2 = __expf(2.f * xsv); xsv = 1.f - 2.f * __builtin_amdgcn_rcpf(e2 + 1.f); }
                        const float xo = __shfl_xor(xsv, 1);
                        if (!(i & 1)) actP[(i >> 1) * 16 + tok] = cvtpk(xsv, xo); }
                    __syncthreads();
                    unsigned pur[17], puk[17], puv[17];
#pragma unroll
                    for (int tok = 0; tok < 17; ++tok) { if (tok == 0 && first) { pur[0] = puk[0] = puv[0] = 0u; continue; }
                        const bf16_t* pp = proj + (size_t)(m0 + tok - 1) * NPAD + c0; pur[tok] = *(const unsigned*)pp; puk[tok] = *(const unsigned*)(pp + RW); puv[tok] = *(const unsigned*)(pp + 2 * RW); }
                    float lw[16][2], la[16][2];
#pragma unroll
                    for (int t = 0; t < 16; ++t) { lw[t][0] = 0.f; lw[t][1] = 0.f; la[t][0] = 0.f; la[t][1] = 0.f; }
                    u32x2 wvn = *(const u32x2*)(w2pl + c0), avn = *(const u32x2*)(w2pl + (size_t)32 * RW + c0);
                    for (int ip = 0; ip < 32; ++ip) {
                        const u32x2 wv = wvn, av = avn;
                        { const int ipn = ip < 31 ? ip + 1 : 31; wvn = *(const u32x2*)(w2pl + (size_t)ipn * RW + c0); avn = *(const u32x2*)(w2pl + (size_t)(32 + ipn) * RW + c0); }
#pragma unroll
                        for (int tq = 0; tq < 4; ++tq) { const u32x4 x4 = *(LAS const u32x4*)(actP + ip * 16 + tq * 4), y4 = *(LAS const u32x4*)(actP + (32 + ip) * 16 + tq * 4);
#pragma unroll
                            for (int e = 0; e < 4; ++e) { lw[tq * 4 + e][0] = DOT2(x4[e], wv.x, lw[tq * 4 + e][0]); lw[tq * 4 + e][1] = DOT2(x4[e], wv.y, lw[tq * 4 + e][1]);
                                                          la[tq * 4 + e][0] = DOT2(y4[e], av.x, la[tq * 4 + e][0]); la[tq * 4 + e][1] = DOT2(y4[e], av.y, la[tq * 4 + e][1]); } }
                    }
                    float pr[2], pk[2], pv[2];
                    if (first) { if (smp) { pr[0] = shst[c0]; pr[1] = shst[c0 + 1]; pk[0] = shst[RW + c0]; pk[1] = shst[RW + c0 + 1]; pv[0] = shst[2 * RW + c0]; pv[1] = shst[2 * RW + c0 + 1]; }
                                 else { pr[0] = pr[1] = pk[0] = pk[1] = pv[0] = pv[1] = 0.f; } }
                    else { const unsigned ur = pur[0], uk = puk[0], uv = puv[0];
                           pr[0] = bflo(ur); pr[1] = bfhi(ur); pk[0] = bflo(uk); pk[1] = bfhi(uk); pv[0] = bflo(uv); pv[1] = bfhi(uv); }
#pragma unroll
                    for (int tok = 0; tok < 16; ++tok) {
                        const int m = m0 + tok;
                        const unsigned ur = pur[tok + 1], uk = puk[tok + 1], uv = puv[tok + 1];
                        const float cr[2] = {bflo(ur), bfhi(ur)}, ck[2] = {bflo(uk), bfhi(uk)}, cv[2] = {bflo(uv), bfhi(uv)};
                        float rr[2], kk[2], vv[2], dec[2], aa[2], kkn[2], km[2], bb[2];
                        rr[0] = cr[0] + (pr[0] - cr[0]) * mu_r.x; rr[1] = cr[1] + (pr[1] - cr[1]) * mu_r.y;
                        kk[0] = ck[0] + (pk[0] - ck[0]) * mu_k.x; kk[1] = ck[1] + (pk[1] - ck[1]) * mu_k.y;
                        vv[0] = cv[0] + (pv[0] - cv[0]) * mu_v.x; vv[1] = cv[1] + (pv[1] - cv[1]) * mu_v.y;
                        dec[0] = __expf(-0.6065306597126334f * sigmoidf_(w0v.x + lw[tok][0])); dec[1] = __expf(-0.6065306597126334f * sigmoidf_(w0v.y + lw[tok][1]));
                        aa[0] = sigmoidf_(a0v.x + la[tok][0]); aa[1] = sigmoidf_(a0v.y + la[tok][1]);
                        kkn[0] = kk[0] * kkw.x; kkn[1] = kk[1] * kkw.y;
                        const float ssq = sum32(kkn[0] * kkn[0] + kkn[1] * kkn[1]);
                        const float inv = rsqrtf(ssq + 1e-12f);
                        kkn[0] *= inv; kkn[1] *= inv;
                        km[0] = kk[0] * (1.f + (aa[0] - 1.f) * kaw.x); km[1] = kk[1] * (1.f + (aa[1] - 1.f) * kaw.y);
                        bb[0] = kkn[0] * aa[0]; bb[1] = kkn[1] * aa[1];
                        const float rkd = sum32(rr[0] * km[0] * rkw.x + rr[1] * km[1] * rkw.y);
                        if (kp == 0) rkdot[(size_t)m * 16 + h] = rkd;
                        char* rec = scanrec + (rec0 + tok) * REC;
                        *(f32x2*)(rec + kp * 8) = (f32x2){dec[0], dec[1]};
                        *(f32x2*)(rec + 256 + kp * 8) = (f32x2){kkn[0], kkn[1]};
                        *(f32x2*)(rec + 512 + kp * 8) = (f32x2){bb[0], bb[1]};
                        *(unsigned*)(rec + 768 + kp * 4) = cvtpk(rr[0], rr[1]);
                        *(unsigned*)(rec + 896 + kp * 4) = cvtpk(km[0], km[1]);
                        *(unsigned*)(rec + 1024 + kp * 4) = cvtpk(vv[0], vv[1]);
                        pr[0] = cr[0]; pr[1] = cr[1]; pk[0] = ck[0]; pk[1] = ck[1]; pv[0] = cv[0]; pv[1] = cv[1];
                    }
                }
                __syncthreads();
            }
            {
                const float* gq = args.in[23] + (size_t)l * QL; const float* gkv = args.in[24] + (size_t)l * KVL; const float* gkr = args.in[31] + (size_t)l * ROPE;
                const float* cw = args.in[32] + (size_t)l * 3 * CONVD; const float* cb = args.in[33] + (size_t)l * CONVD;
                f32x4 gq4[4]; gq4[0] = *(const f32x4*)(gq + lane * 8); gq4[1] = *(const f32x4*)(gq + lane * 8 + 4); gq4[2] = *(const f32x4*)(gq + 512 + lane * 8); gq4[3] = *(const f32x4*)(gq + 512 + lane * 8 + 4);
                const f32x4 gkv0 = *(const f32x4*)(gkv + lane * 8), gkv1 = *(const f32x4*)(gkv + lane * 8 + 4); const float gkr1 = gkr[lane];
                for (int m = gw; m < M; m += ngw) {
                    const bool smp = m >= MP;
                    const int b = smp ? ((m - MP) >> 5) : (m >> 12), t = smp ? ((m - MP) & 31) : (m & 4095);
                    const int pos = smp ? PAST + t : t;
                    const int T = smp ? DS : SEQ;
                    const size_t lrow = smp ? (size_t)MP + (size_t)b * SKEYS + PAST + t : (size_t)m;
                    float* lat_out = smp ? out + O_LATS + ((size_t)(l * DB + b) * DS + t) * KVL : out + O_LATP + ((size_t)(l * NB + b) * SEQ + t) * KVL;
                    float* kr_out = smp ? out + O_KRS + ((size_t)(l * DB + b) * DS + t) * ROPE : out + O_KRP + ((size_t)(l * NB + b) * SEQ + t) * ROPE;
                    const bf16_t* prow = proj + (size_t)m * NPAD;
                    const u32x4 rq0 = *(const u32x4*)(prow + C_CQ + lane * 8), rq1 = *(const u32x4*)(prow + C_CQ + 512 + lane * 8), rkv = *(const u32x4*)(prow + C_CKV + lane * 8);
                    const bf16_t rkr = prow[C_KR + lane];
                    u32x4 rgt[6];
#pragma unroll
                    for (int j = 0; j < 6; ++j) { const int c = j * 512 + lane * 8; rgt[j] = *(const u32x4*)(prow + (c < RW ? C_RWGATE + c : C_MGATE + (c - RW))); }
                    const bf16_t* prow1 = t >= 1 ? prow - NPAD : prow; const bf16_t* prow2 = t >= 2 ? prow - 2 * NPAD : prow;
                    u32x4 rcc[2][3], rcx[2][3], rvb[2], rvg[2];
#pragma unroll
                    for (int j = 0; j < 2; ++j) { const int c = j * 512 + lane * 8;
                        rcc[j][0] = *(const u32x4*)(prow + C_CVC + c); rcx[j][0] = *(const u32x4*)(prow + C_CVX + c);
                        rcc[j][1] = *(const u32x4*)(prow1 + C_CVC + c); rcx[j][1] = *(const u32x4*)(prow1 + C_CVX + c);
                        rcc[j][2] = *(const u32x4*)(prow2 + C_CVC + c); rcx[j][2] = *(const u32x4*)(prow2 + C_CVX + c);
                        rvb[j] = *(const u32x4*)(prow + C_CVB + c); rvg[j] = *(const u32x4*)(prow + C_CVG + c); }
                    const float2 cs = tab[pos * 32 + (lane & 31)];
                    f32x4 cbw[2][8];
#pragma unroll
                    for (int j = 0; j < 2; ++j) { const int c = j * 512 + lane * 8;
#pragma unroll
                        for (int hh = 0; hh < 2; ++hh) { cbw[j][hh] = *(const f32x4*)(cb + c + 4 * hh); cbw[j][2 + hh] = *(const f32x4*)(cw + c + 4 * hh);
                            cbw[j][4 + hh] = *(const f32x4*)(cw + CONVD + c + 4 * hh); cbw[j][6 + hh] = *(const f32x4*)(cw + 2 * CONVD + c + 4 * hh); } }
                    {
                        float f[16]; unpack8(rq0, f); unpack8(rq1, f + 8);
                        float ss = 0.f;
#pragma unroll
                        for (int e = 0; e < 16; ++e) ss += f[e] * f[e];
                        const float rstd = rsqrtf(wave_sum(ss) * (1.f / QL) + NORM_EPS);
#pragma unroll
                        for (int j = 0; j < 2; ++j) { const f32x4 g0 = gq4[2 * j], g1 = gq4[2 * j + 1];
                            float y[8];
#pragma unroll
                            for (int e = 0; e < 4; ++e) { y[e] = f[j * 8 + e] * rstd * g0[e]; y[4 + e] = f[j * 8 + 4 + e] * rstd * g1[e]; }
                            *(u32x4*)(qin + (size_t)m * QL + j * 512 + lane * 8) = pack8(y); }
                    }
                    {
                        float f[8]; unpack8(rkv, f);
                        float ss = 0.f;
#pragma unroll
                        for (int e = 0; e < 8; ++e) ss += f[e] * f[e];
                        const float rstd = rsqrtf(wave_sum(ss) * (1.f / KVL) + NORM_EPS);
                        const f32x4 g0 = gkv0, g1 = gkv1;
                        float y[8];
#pragma unroll
                        for (int e = 0; e < 4; ++e) { y[e] = f[e] * rstd * g0[e]; y[4 + e] = f[4 + e] * rstd * g1[e]; }
                        *(f32x4*)(lat_out + lane * 8) = (f32x4){y[0], y[1], y[2], y[3]}; *(f32x4*)(lat_out + lane * 8 + 4) = (f32x4){y[4], y[5], y[6], y[7]};
                        *(u32x4*)(latall + lrow * KVL + lane * 8) = pack8(y);
                    }
                    {
                        const float x = bf2f(rkr);
                        const float rstd = rsqrtf(wave_sum(x * x) * (1.f / ROPE) + NORM_EPS);
                        const float y = x * rstd * gkr1;
                        const float pt = __shfl_xor(y, 32);
                        const float o = lane < 32 ? y * cs.x - pt * cs.y : y * cs.x + pt * cs.y;
                        kr_out[lane] = o; Krb[lrow * ROPE + lane] = f2bf(o);
                    }
                    {
                        const float* cbuf = args.in[8] + (size_t)(l * DB + b) * 2 * CONVD;
                        float* cv_out = smp ? out + O_CVS + (size_t)(l * DB + b) * 2 * CONVD : out + O_CVP + (size_t)(l * NB + b) * 2 * CONVD;
#pragma unroll
                        for (int j = 0; j < 2; ++j) {
                            const int c = j * 512 + lane * 8;
                            float u0[8], u1[8], u2[8], fa[8], fb[8];
                            unpack8(rcc[j][0], fa); unpack8(rcx[j][0], fb);
#pragma unroll
                            for (int e = 0; e < 8; ++e) u0[e] = fa[e] * fb[e];
                            if (t >= 1) { unpack8(rcc[j][1], fa); unpack8(rcx[j][1], fb);
#pragma unroll
                                for (int e = 0; e < 8; ++e) u1[e] = fa[e] * fb[e]; }
                            else {
#pragma unroll
                                for (int e = 0; e < 8; ++e) u1[e] = smp ? cbuf[CONVD + c + e] : 0.f; }
                            if (t >= 2) { unpack8(rcc[j][2], fa); unpack8(rcx[j][2], fb);
#pragma unroll
                                for (int e = 0; e < 8; ++e) u2[e] = fa[e] * fb[e]; }
                            else {
#pragma unroll
                                for (int e = 0; e < 8; ++e) u2[e] = smp ? cbuf[t * CONVD + c + e] : 0.f; }
                            float vb[8], vg[8], y[8];
                            unpack8(rvb[j], vb); unpack8(rvg[j], vg);
#pragma unroll
                            for (int e = 0; e < 8; ++e) { const float yy = cbw[j][e >> 2][e & 3] + u2[e] * cbw[j][2 + (e >> 2)][e & 3] + u1[e] * cbw[j][4 + (e >> 2)][e & 3] + u0[e] * cbw[j][6 + (e >> 2)][e & 3];
                                y[e] = vb[e] * yy * siluf_(vg[e]); }
                            *(u32x4*)(hmix + (size_t)m * DM + 3072 + c) = pack8(y);
                            if (t >= T - 2) { float* co = cv_out + (size_t)(t - (T - 2)) * CONVD + c;
                                *(f32x4*)co = (f32x4){u0[0], u0[1], u0[2], u0[3]}; *(f32x4*)(co + 4) = (f32x4){u0[4], u0[5], u0[6], u0[7]}; }
                        }
                    }
#pragma unroll
                    for (int j = 0; j < 6; ++j) {
                        const int c = j * 512 + lane * 8;
                        float f[8]; unpack8(rgt[j], f);
#pragma unroll
                        for (int e = 0; e < 8; ++e) f[e] = siluf_(f[e]);
                        *(u32x4*)(hmix + (size_t)m * DM + c) = pack8(f);
                    }
                }
            }
            {
                const float* clat = args.in[4] + (size_t)l * DB * PAST * KVL; const float* ckr = args.in[5] + (size_t)l * DB * PAST * ROPE;
                if (G == 256) {
                    for (int r0 = gw; r0 < DB * PAST; r0 += 4 * 2048) {
                        f32x4 a0[4], a1[4]; float kx[4];
#pragma unroll
                        for (int q = 0; q < 4; ++q) { const int r = r0 + q * 2048;
                            a0[q] = *(const f32x4*)(clat + (size_t)r * KVL + lane * 8); a1[q] = *(const f32x4*)(clat + (size_t)r * KVL + lane * 8 + 4); kx[q] = ckr[(size_t)r * ROPE + lane]; }
#pragma unroll
                        for (int q = 0; q < 4; ++q) { const int r = r0 + q * 2048;
                            const int b = r >> 11, p = r & 2047; const size_t lrow = (size_t)MP + (size_t)b * SKEYS + p;
                            u32x4 w; w.x = cvtpk(a0[q].x, a0[q].y); w.y = cvtpk(a0[q].z, a0[q].w); w.z = cvtpk(a1[q].x, a1[q].y); w.w = cvtpk(a1[q].z, a1[q].w);
                            *(u32x4*)(latall + lrow * KVL + lane * 8) = w;
                            Krb[lrow * ROPE + lane] = f2bf(kx[q]); }
                    }
                } else {
                    for (int r = gw; r < DB * PAST; r += ngw) {
                        const int b = r >> 11, p = r & 2047; const size_t lrow = (size_t)MP + (size_t)b * SKEYS + p;
                        const f32x4 a0 = *(const f32x4*)(clat + (size_t)r * KVL + lane * 8), a1 = *(const f32x4*)(clat + (size_t)r * KVL + lane * 8 + 4);
                        u32x4 w; w.x = cvtpk(a0.x, a0.y); w.y = cvtpk(a0.z, a0.w); w.z = cvtpk(a1.x, a1.y); w.w = cvtpk(a1.z, a1.w);
                        *(u32x4*)(latall + lrow * KVL + lane * 8) = w;
                        Krb[lrow * ROPE + lane] = f2bf(ckr[(size_t)r * ROPE + lane]);
                    }
                }
            }
            for (int i = bx * 512 + tid; i < 20 * SHIFT_DIM; i += G * 512) {
                const int seq = i / SHIFT_DIM, col = i % SHIFT_DIM;
                const int mlast = seq < 4 ? seq * SEQ + SEQ - 1 : MP + (seq - 4) * DS + DS - 1;
                float* dst = seq < 4 ? out + O_SHP + (size_t)(l * NB + seq) * SHIFT_DIM : out + O_SHS + (size_t)(l * DB + (seq - 4)) * SHIFT_DIM;
                dst[col] = bf2f(proj[(size_t)mlast * NPAD + col]);
            }
        }
        SEAM(pb + 2);
        if (IN(pb + 3) && EN(5)) {
            {
                PHASE_LOCALS
                char* chkb = (char*)(ws + WS_CHK);
                LAS char* wl = (LAS char*)lds + wave * 16384;
                constexpr int NIT = NB * 16 * (SEQ / 16) + DB * 16 * (DS / 16), NPR = NB * 16 * (SEQ / 16);
#define REC_OF(it_) ((it_) < NPR ? scanrec + (size_t)(it_) * 16 * REC   : scanrec + ((size_t)SREC_S0 + (size_t)((it_) - NPR) * 16) * REC)
#pragma unroll 1
                for (int it = gw; it < NIT; it += ngw) chk::precompute(REC_OF(it), chkb + (size_t)it * chk::CHKB, wl, lane);
#undef REC_OF
            }
            xcd_barrier(bar);
            {
                PHASE_LOCALS
                const char* chkb = (const char*)(ws + WS_CHK);
                const bool split = (G == 256);
                const bool do_gemm = !split || bx >= 64, do_scan = !split || bx < 64;
                const int GG = split ? 192 : G, gc = split ? bx - 64 : bx;
                if (do_gemm) {
                    if (EN(10)) { pg8::Gemm g{qin, wtuq, M, QW, QL}; pg8::StaticOrder S; S.init(M, QW, GG, gc);
                      pg8::EpiBf16 E{Qb, QW, 0, 0};
                      pg8::gemm_phase<pg8::EpiBf16, pg8::StaticOrder, true, true>(lds, g, S, E); }
                }
                if (EN(11)) {
                    pg8::Gemm g{latall, wtukv, KROWS, 2 * MLAD, KVL};
                    pg8::EpiKV E{Kn, Vb, args.in[30] + (size_t)l * 128, (LAS float*)(lds + XL_OFF)};
                    if (split) { pg8::KvOrder S; S.init(KROWS, 2 * MLAD, bx); pg8::gemm_phase<pg8::EpiKV, pg8::KvOrder, true, true>(lds, g, S, E); }
                    else { pg8::StaticOrder S; S.init(KROWS, 2 * MLAD, G, (bx + G / 2) % G); pg8::gemm_phase<pg8::EpiKV, pg8::StaticOrder, true, true>(lds, g, S, E); }
                }
                __syncthreads();
                if (do_scan && EN(9)) {
                    const int sw = split ? bx : bx, nsw = split ? 64 : G;
#pragma unroll 1
                    for (int bh = sw; bh < NB * 16; bh += nsw) {
                        const int b = bh >> 4, h = bh & 15;
                        chk::seq_wg(chkb + (size_t)bh * (SEQ / 16) * chk::CHKB, SEQ / 16, nullptr, obuf + (size_t)b * SEQ * RW + h * 64,
                                    out + O_RWP + ((size_t)(l * NB + b) * 16 + h) * 4096, (LAS char*)lds, wave, lane);
                    }
#pragma unroll 1
                    for (int bh = sw; bh < DB * 16; bh += nsw) {
                        const int b = bh >> 4, h = bh & 15;
                        chk::seq_wg(chkb + ((size_t)NB * 16 * (SEQ / 16) + (size_t)bh * (DS / 16)) * chk::CHKB, DS / 16, args.in[6] + ((size_t)(l * DB + b) * 16 + h) * 4096,
                                    obuf + ((size_t)MP + (size_t)b * DS) * RW + h * 64, out + O_RWS + ((size_t)(l * DB + b) * 16 + h) * 4096, (LAS char*)lds, wave, lane);
                    }
                    __syncthreads();
                }
            }
        }
        SEAM(pb + 3);
        if (IN(pb + 4) && EN(6)) {
            PHASE_LOCALS
            const float* lng = args.in[21] + (size_t)l * RW; const float* lnb = args.in[22] + (size_t)l * RW;
            const int l16 = lane & 15, g16 = lane >> 4;
            for (int m = gw; m < M; m += ngw) {
                const bool smp = m >= MP;
                const int b = smp ? ((m - MP) >> 5) : (m >> 12), t = smp ? ((m - MP) & 31) : (m & 4095);
                f32x4 ov4[4], lg4[4], lb4[4]; u32x2 vu4[4], gg4[4]; float rk4[4];
#pragma unroll
                for (int p = 0; p < 4; ++p) {
                    const int h = p * 4 + g16, c = h * 64 + l16 * 4;
                    const size_t rec = smp ? (size_t)SREC_S0 + (size_t)(b * 16 + h) * DS + t : (size_t)(b * 16 + h) * SEQ + t;
                    ov4[p] = *(const f32x4*)(obuf + (size_t)m * RW + c); vu4[p] = *(const u32x2*)(scanrec + rec * REC + 1024 + l16 * 8); rk4[p] = rkdot[(size_t)m * 16 + h];
                    lg4[p] = *(const f32x4*)(lng + c); lb4[p] = *(const f32x4*)(lnb + c); gg4[p] = *(const u32x2*)(hmix + (size_t)m * DM + c); }
#pragma unroll
                for (int p = 0; p < 4; ++p) {
                    const int h = p * 4 + g16, c = h * 64 + l16 * 4;
                    const f32x4 ov = ov4[p];
                    const float mu_ = sum16((ov.x + ov.y) + (ov.z + ov.w)) * (1.f / 64);
                    const f32x4 d = ov - mu_;
                    const float var = sum16((d.x * d.x + d.y * d.y) + (d.z * d.z + d.w * d.w)) * (1.f / 64);
                    const float rstd = rsqrtf(var + 64e-5f);
                    const u32x2 vu = vu4[p]; const f32x4 vv = {bflo(vu.x), bfhi(vu.x), bflo(vu.y), bfhi(vu.y)};
                    const float rk = rk4[p];
                    const f32x4 lg = lg4[p], lb = lb4[p];
                    u32x2* gp = (u32x2*)(hmix + (size_t)m * DM + c); const u32x2 gg = gg4[p];
                    const float y0 = (d.x * rstd * lg.x + lb.x + rk * vv.x) * bflo(gg.x), y1 = (d.y * rstd * lg.y + lb.y + rk * vv.y) * bfhi(gg.x);
                    const float y2 = (d.z * rstd * lg.z + lb.z + rk * vv.z) * bflo(gg.y), y3 = (d.w * rstd * lg.w + lb.w + rk * vv.w) * bfhi(gg.y);
                    u32x2 w; w.x = cvtpk(y0, y1); w.y = cvtpk(y2, y3); *gp = w;
                }
            }
        }
        if (ATT_PROBE) { SEAM(pb + 4); }
        if (IN(pb + 5) && EN(7)) {
            PHASE_LOCALS
            const float* gqn = args.in[28] + (size_t)l * 128; const float* gqr = args.in[29] + (size_t)l * ROPE;
            for (int v = bx; v < 256; v += G) {
                const int vv = (G == 256) ? ((v & 7) * 32 + (v >> 3)) : v;
                const int bh = vv >> 2, s = vv & 3, b = bh >> 4, h = bh & 15;
#pragma unroll 1
                for (int i = 0; i < 4; ++i) {
                    const int qb = (i == 0) ? 15 - s : (i == 1) ? s : (i == 2) ? 11 - s : 4 + s;
                    const size_t m0 = (size_t)b * SEQ + (size_t)qb * 256, k0 = (size_t)b * SEQ;
                    att::AUnit u{Qb + m0 * QW + h * 192, Kn + ((size_t)h * KROWS + k0) * 128, Vb + ((size_t)h * KROWS + k0) * 128, Krb + k0 * ROPE, hmix + m0 * DM + RW + h * 128, 4 * qb + 4, 8, 4 * qb, 0, qb * 256, gqn, gqr, tab};
                    att::attn_unit<0>(u, (LAS char*)lds);
                    if (ATT_PROBE) { att::AUnit u2 = u; u2.O = (bf16_t*)(ws + WS_SCAN) + (u.O - hmix); att::attn_unit<(ATT_PROBE == 4 ? 0 : ATT_PROBE)>(u2, (LAS char*)lds); }
                }
                {
                    const int sb = v >> 4, sh = v & 15;
                    const size_t m0 = (size_t)MP + (size_t)sb * DS, k0 = (size_t)MP + (size_t)sb * SKEYS;
                    att::AUnit u{Qb + m0 * QW + sh * 192, Kn + ((size_t)sh * KROWS + k0) * 128, Vb + ((size_t)sh * KROWS + k0) * 128, Krb + k0 * ROPE, hmix + m0 * DM + RW + sh * 128, 33, 1, 32, 1, PAST, gqn, gqr, tab};
                    att::attn_unit<0>(u, (LAS char*)lds);
                }
            }
        }
        SEAM(pb + 5);
        if (IN(pb + 6) && EN(8)) {
            PHASE_LOCALS
            if (G == 256) {
                { pg8::Gemm g{hmix, wtout, MP, DM, DM, 0}; pg8::StaticOrder S; S.init(MP, DM, G, bx);
                  pg8::EpiResGate E{xp, xs, out + O_YP, modf_l + 2 * DM};
                  pg8::gemm_phase<pg8::EpiResGate, pg8::StaticOrder, true, true>(lds, g, S, E); }
                { const int un = bx >> 3, ks = bx & 7;
                  pg8::Gemm g{hmix + ks * 512, wtout + ks * 512, M, DM, 512, DM}; pg8::OneUnit S{MP / 256 + (un >> 4), un & 15};
                  pg8::EpiPart E{(float*)(ws + WS_PART) + (size_t)bx * 65536};
                  pg8::gemm_phase<pg8::EpiPart, pg8::OneUnit, true, true>(lds, g, S, E); }
                if (l + 1 < DEPTH) convert_weights(args, l + 1, lds, gw, ngw, wave, lane, 5, nullptr);
                xcd_barrier(bar);
                {
                    const float* part = (const float*)(ws + WS_PART); const float* gate = modf_l + 2 * DM;
                    f32x4 ra[4], rx[4], rg[4];
#pragma unroll
                    for (int q = 0; q < 4; ++q) { const int idx = q * (G * 512) + bx * 512 + tid, r = idx >> 10, c = (idx & 1023) * 4;
                        const float* pp = part + ((size_t)(((r >> 8) * 16 + (c >> 8)) * 8) * 65536 + (size_t)(r & 255) * 256 + (c & 255));
                        f32x4 a = *(const f32x4*)pp;
#pragma unroll
                        for (int k2 = 1; k2 < 8; ++k2) a += *(const f32x4*)(pp + (size_t)k2 * 65536);
                        ra[q] = a; rx[q] = *(const f32x4*)(xs + (size_t)r * DM + c); rg[q] = *(const f32x4*)(gate + (size_t)(4 + (r >> 5)) * (3 * DM) + c); }
#pragma unroll
                    for (int q = 0; q < 4; ++q) { const int idx = q * (G * 512) + bx * 512 + tid, r = idx >> 10, c = (idx & 1023) * 4;
                        *(f32x4*)(out + O_YS + (size_t)r * DM + c) = rx[q] + rg[q] * ra[q]; }
                }
            } else {
                pg8::Gemm g{hmix, wtout, M, DM, DM, 0}; pg8::StaticOrder S; S.init(M, DM, G, bx);
                pg8::EpiResGate E{xp, xs, out + O_YP, modf_l + 2 * DM};
                pg8::gemm_phase<pg8::EpiResGate, pg8::StaticOrder, true, true>(lds, g, S, E);
                if (l + 1 < DEPTH) convert_weights(args, l + 1, lds, gw, ngw, wave, lane, 5, (unsigned*)(ws + WS_CTL) + CW_TICKET + 64 * l);
            }
        }
        SEAM(pb + 6);
    }
#undef IN
#undef SEAM
}

extern "C" void kernel_launch(void* const* d_in, const int* in_sizes, int n_in, void* d_out, int out_size, void* d_ws, size_t ws_size, hipStream_t stream) {
    static int grid = 0;
    if (grid == 0) {
        if (n_in != 35 || (size_t)out_size != O_END || ws_size < WS_END) { fprintf(stderr, "kernel_launch: shape mismatch (n_in %d, out %d, ws %zu)\n", n_in, out_size, ws_size); grid = -1; return; }
        int dev = 0, cus = 0, per_cu = 0;
        if (hipGetDevice(&dev) != hipSuccess || hipDeviceGetAttribute(&cus, hipDeviceAttributeMultiprocessorCount, dev) != hipSuccess) { grid = -1; return; }
        if (hipFuncSetAttribute((const void*)mk_fwd, hipFuncAttributeMaxDynamicSharedMemorySize, LDS_BYTES) != hipSuccess) { fprintf(stderr, "kernel_launch: hipFuncSetAttribute failed\n"); grid = -1; return; }
        if (hipOccupancyMaxActiveBlocksPerMultiprocessor(&per_cu, (const void*)mk_fwd, NWAVES * 64, LDS_BYTES) != hipSuccess || per_cu < 1) { fprintf(stderr, "kernel_launch: occupancy query reports %d\n", per_cu); }
        (void)hipGetLastError();
        grid = cus;
    }
    if (grid < 0) return;
    if (hipMemsetAsync((char*)d_ws + WS_CTL, 0, CTL_ZERO_BYTES, stream) != hipSuccess) return;
    Args a{};
    for (int i = 0; i < 35; ++i) a.in[i] = (const float*)d_in[i];
    a.out = (float*)d_out; a.ws = (unsigned char*)d_ws;
    constexpr int NL = MK_N_LAUNCHES;
    for (int li = 0; li < NL; ++li) {
        a.ph_lo = (NL == 1) ? 0 : li; a.ph_hi = (NL == 1) ? NPHASE : li + 1; a.li = li; a.pad = 0;
        hipLaunchKernelGGL(mk_fwd, dim3(grid), dim3(NWAVES * 64), LDS_BYTES, stream, a);
        const hipError_t le = hipPeekAtLastError();
        if (le != hipSuccess) { fprintf(stderr, "kernel_launch: launch %d failed: %s\n", li, hipGetErrorName(le)); break; }
    }
}
```

```cpp
#include <hip/hip_runtime.h>
#include <cstdio>
#include <cstdint>

#ifndef MK_N_LAUNCHES
#define MK_N_LAUNCHES 1
#endif

#ifndef PROBE_DUP
#define PROBE_DUP -1
#endif
#define REPS(k) ((PROBE_DUP) == (k) ? 2 : 1)
#ifndef ATT_PROBE
#define ATT_PROBE 0
#endif
#ifndef EN_MASK
#define EN_MASK 0xFFFF
#endif
#define EN(k) (((EN_MASK) >> (k)) & 1)
#define GAS __attribute__((address_space(1)))
#define LAS __attribute__((address_space(3)))
typedef unsigned short bf16_t;
typedef short bf16x8 __attribute__((ext_vector_type(8)));
typedef short s16x4 __attribute__((ext_vector_type(4)));
typedef float f32x2 __attribute__((ext_vector_type(2)));
typedef float f32x4 __attribute__((ext_vector_type(4)));
typedef float f32x16 __attribute__((ext_vector_type(16)));
typedef unsigned u32x2 __attribute__((ext_vector_type(2)));
typedef unsigned u32x4 __attribute__((ext_vector_type(4)));

constexpr int DM = 4096, NB = 4, SEQ = 4096, DEPTH = 2, DB = 16, DS = 32, PAST = 2048;
constexpr int MP = NB * SEQ, MS = DB * DS, M = MP + MS;
constexpr int RW = 1024, SHIFT_DIM = 3200, QL = 1024, KVL = 512, ROPE = 64, MLAD = 2048, CONVD = 1024;
constexpr int IN_COLS = 11968, NPAD = 12032;
constexpr int C_RWGATE = 3200, C_CQ = 4224, C_CKV = 5248, C_KR = 5760, C_MGATE = 5824, C_CVB = 7872, C_CVC = 8896, C_CVX = 9920, C_CVG = 10944;
constexpr int SKEYS = PAST + DS;
constexpr int KROWS = MP + DB * SKEYS;
constexpr int QW = 3072;
constexpr float NORM_EPS = 1e-6f;
constexpr float QSCALE = 0.07216878364870323f * 1.4426950408889634f;
constexpr int REC = 1152;
constexpr int SREC_S0 = NB * 16 * SEQ;

constexpr size_t O_YP = 0, O_YS = 67108864, O_LATP = 69206016, O_KRP = 85983232, O_RWP = 88080384, O_SHP = 88604672, O_CVP = 88630272,
                 O_LATS = 88646656, O_KRS = 89170944, O_RWS = 89236480, O_SHS = 91333632, O_CVS = 91436032, O_END = 91501568;

constexpr size_t MiB = 1u << 20;
constexpr size_t WS_CTL = 0, CTL_ZERO_BYTES = 1 * MiB;
constexpr size_t WS_TAB = 1 * MiB;
constexpr size_t WS_MODP = 2 * MiB;
constexpr size_t WS_QIN = 2 * MiB;
constexpr size_t WS_MODF = 35 * MiB;
constexpr size_t WS_RKDOT = 37 * MiB;
constexpr size_t WS_W2P = 37 * MiB + 1280 * 1024;
constexpr size_t WS_WTIN = 39 * MiB;
constexpr size_t WS_OBUF = 39 * MiB;
constexpr size_t WS_WTOUT = 133 * MiB;
constexpr size_t WS_WTUQ = 165 * MiB;
constexpr size_t WS_WTUKV = 171 * MiB;
constexpr size_t WS_HMIX = 175 * MiB;
constexpr size_t WS_PROJ = 307 * MiB;
constexpr size_t WS_KN = WS_PROJ;
constexpr size_t WS_V = WS_PROJ + (size_t)KROWS * 2048 * 2;
constexpr size_t WS_SCAN = 696 * MiB;
constexpr size_t WS_PART = 994 * MiB;
constexpr size_t WS_Q = 1092 * MiB;
constexpr size_t WS_LAT = 1191 * MiB;
constexpr size_t WS_KR = 1240 * MiB;
constexpr size_t WS_CHK = 1247 * MiB;
constexpr size_t WS_END = 1496 * MiB;
static_assert(WS_V + (size_t)(KROWS + 64) * 2048 * 2 <= WS_SCAN, "ws map");
static_assert((KROWS / 256) * (2 * MLAD / 256) == 3104 && (M / 256) * (QW / 256) == 792, "KvOrder's unit counts");
static_assert(WS_PROJ + (size_t)M * NPAD * 2 <= WS_SCAN, "ws map");
static_assert(WS_SCAN + (size_t)(SREC_S0 + DB * 16 * DS) * REC <= WS_PART && WS_PART + (size_t)32 * 8 * 65536 * 4 <= WS_Q, "ws map");
static_assert(WS_CHK + (size_t)(NB * 16 * (SEQ / 16) + DB * 16 * (DS / 16)) * 15360 <= WS_END, "ws map");
static_assert(WS_RKDOT + (size_t)M * 16 * 4 <= WS_W2P && WS_W2P + 512 * 1024 <= WS_WTIN, "ws map");
static_assert(WS_OBUF + (size_t)M * RW * 4 <= WS_WTOUT && WS_QIN + (size_t)M * QL * 2 <= WS_MODF && WS_MODP + (size_t)2 * 11 * 20 * 12288 * 4 <= WS_MODF, "ws map");

constexpr int CW_BAR = 4096;
constexpr int CW_TICKET = 2048;

__device__ __forceinline__ float bflo(unsigned u) { return __uint_as_float(u << 16); }
__device__ __forceinline__ float bfhi(unsigned u) { return __uint_as_float(u & 0xffff0000u); }
__device__ __forceinline__ float bf2f(bf16_t b) { return __uint_as_float((unsigned)b << 16); }
__device__ __forceinline__ unsigned cvtpk(float lo, float hi) { unsigned r; asm volatile("v_cvt_pk_bf16_f32 %0, %1, %2" : "=v"(r) : "v"(lo), "v"(hi)); return r; }
__device__ __forceinline__ bf16_t f2bf(float f) { return (bf16_t)(cvtpk(f, 0.f) & 0xffffu); }
__device__ __forceinline__ float wave_sum(float v) {
#pragma unroll
    for (int o = 32; o >= 1; o >>= 1) v += __shfl_xor(v, o);
    return v;
}
__device__ __forceinline__ float sum16(float v) { v += __shfl_xor(v, 1); v += __shfl_xor(v, 2); v += __shfl_xor(v, 4); v += __shfl_xor(v, 8); return v; }
template <int CTRL> __device__ __forceinline__ float dppx_(float x) { return __int_as_float(__builtin_amdgcn_update_dpp(0, __float_as_int(x), CTRL, 0xf, 0xf, true)); }
__device__ __forceinline__ float sum32(float v) {
    v += dppx_<0xB1>(v); v += dppx_<0x4E>(v); v += dppx_<0x141>(v); v += dppx_<0x140>(v); v += __shfl_xor(v, 16); return v; }
typedef __bf16 bf16x2_t __attribute__((ext_vector_type(2)));
#define DOT2(a_, b_, c_) __builtin_amdgcn_fdot2_f32_bf16(__builtin_bit_cast(bf16x2_t, (unsigned)(a_)), __builtin_bit_cast(bf16x2_t, (unsigned)(b_)), (c_), false)
__device__ __forceinline__ float sigmoidf_(float x) { return __builtin_amdgcn_rcpf(1.0f + __expf(-x)); }
__device__ __forceinline__ float siluf_(float x) { return x * __builtin_amdgcn_rcpf(1.0f + __expf(-x)); }
__device__ __forceinline__ void unpack8(u32x4 u, float* f) {
    f[0] = bflo(u.x); f[1] = bfhi(u.x); f[2] = bflo(u.y); f[3] = bfhi(u.y); f[4] = bflo(u.z); f[5] = bfhi(u.z); f[6] = bflo(u.w); f[7] = bfhi(u.w);
}
__device__ __forceinline__ u32x4 pack8(const float* f) { u32x4 w; w.x = cvtpk(f[0], f[1]); w.y = cvtpk(f[2], f[3]); w.z = cvtpk(f[4], f[5]); w.w = cvtpk(f[6], f[7]); return w; }

__constant__ float ROPE_FREQ[32] = {
    1.000000000e+00f, 7.498942614e-01f, 5.623413324e-01f, 4.216965139e-01f, 3.162277639e-01f, 2.371373773e-01f, 1.778279394e-01f, 1.333521307e-01f,
    1.000000015e-01f, 7.498941571e-02f, 5.623413250e-02f, 4.216965288e-02f, 3.162277490e-02f, 2.371373773e-02f, 1.778279431e-02f, 1.333521493e-02f,
    9.999999776e-03f, 7.498941850e-03f, 5.623413250e-03f, 4.216964822e-03f, 3.162277630e-03f, 2.371373586e-03f, 1.778279431e-03f, 1.333521446e-03f,
    1.000000047e-03f, 7.498942432e-04f, 5.623413017e-04f, 4.216965172e-04f, 3.162277571e-04f, 2.371373703e-04f, 1.778279402e-04f, 1.333521504e-04f};

namespace pg8 {
#define PG8_LAS __attribute__((address_space(3)))
constexpr int BM = 256, BK = 64, HALF = 128, HTB = HALF * BK * 2, STAGE_BYTES = 8 * HTB, NXCD = 8, WGM = 8;
__host__ __device__ __forceinline__ int lds_byte(int r, int c) { const int st = (r >> 4) * 2 + (c >> 5), rr = r & 15, cc = c & 31, ob = rr * 64 + cc * 2; return st * 1024 + (ob ^ (((ob >> 9) & 1) << 5)); }
__host__ __device__ __forceinline__ void stage_rc(int b, int& R, int& C) { const int st = b / 1024, sb = b % 1024, swz = sb ^ (((sb >> 9) & 1) << 5); R = (st >> 1) * 16 + swz / 64; C = (st & 1) * 32 + (swz % 64) / 2; }
__host__ __device__ __forceinline__ int perm32(int rho) { const int n = rho >> 4, i = rho & 15; return 8 * (i >> 2) + 4 * n + (i & 3); }

struct Unit { int pm, pn; };
struct Gemm { const bf16_t* A; const bf16_t* Bt; int M, N, K; int ld; };

struct StaticOrder {
    int nM, nN, nwg, G, c;
    __host__ __device__ void init(int M_, int N_, int G_, int c_) { nM = M_ / BM; nN = N_ / BM; nwg = nM * nN; G = G_; c = c_; }
    __host__ __device__ bool next(int i, Unit& u) const {
        const long L = (long)i * G + c; if (L >= nwg) return false;
        int wgid = (int)L; { const int q = nwg / NXCD, r = nwg % NXCD, xcd = wgid % NXCD, off = wgid / NXCD; wgid = (xcd < r ? xcd * (q + 1) : r * (q + 1) + (xcd - r) * q) + off; }
        const int nig = WGM * nN, gid = wgid / nig, fm = gid * WGM, gsz = (nM - fm) < WGM ? (nM - fm) : WGM;
        u.pm = fm + ((wgid % nig) % gsz); u.pn = (wgid % nig) / gsz; return true;
    }
    __device__ __forceinline__ void a_ready(const Unit&) const {}
    __device__ __forceinline__ void done(const Unit&) const {}
};
struct KvOrder {
    int nM, nN, nwg, bx;
    __host__ __device__ void init(int M_, int N_, int bx_) { nM = M_ / BM; nN = N_ / BM; nwg = nM * nN; bx = bx_; }
    __host__ __device__ bool next(int i, Unit& u) const {
        const int gc = bx - 64; int L;
        if (i < 8) L = 256 * i + bx;
        else if (gc < 0) return false;
        else if (i < 12) L = 2048 + 192 * (i - 8) + gc;
        else if (gc < 24) return false;
        else if (i == 12) L = 2816 + (gc - 24);
        else if (i == 13 && gc - 24 < 120) L = 2984 + (gc - 24);
        else return false;
        int wgid = L; { const int q = nwg / NXCD, r = nwg % NXCD, xcd = wgid % NXCD, off = wgid / NXCD; wgid = (xcd < r ? xcd * (q + 1) : r * (q + 1) + (xcd - r) * q) + off; }
        const int nig = WGM * nN, gid = wgid / nig, fm = gid * WGM, gsz = (nM - fm) < WGM ? (nM - fm) : WGM;
        u.pm = fm + ((wgid % nig) % gsz); u.pn = (wgid % nig) / gsz; return true;
    }
    __device__ __forceinline__ void a_ready(const Unit&) const {}
    __device__ __forceinline__ void done(const Unit&) const {}
};

struct OneUnit {
    int pm, pn;
    __host__ __device__ bool next(int i, Unit& u) const { if (i) return false; u.pm = pm; u.pn = pn; return true; }
    __device__ __forceinline__ void a_ready(const Unit&) const {}
    __device__ __forceinline__ void done(const Unit&) const {}
};
struct EpiBf16 {
    static constexpr bool PERM = true, AFTER_DRAIN = false;
    bf16_t* O; int ldc; int split_cols; size_t split_stride;
    __device__ __forceinline__ void operator()(const f32x4 (&acc)[2][2][4][2], const Unit& u, int wr, int wc, int fr, int fq) const {
        const int row0 = u.pm * BM + wr * 64 + fr; int colt = u.pn * BM; bf16_t* base = O;
        if (split_cols) { const int t = colt / split_cols; base += (size_t)t * split_stride; colt -= t * split_cols; }
        const int col0 = colt + wc * 32 + 8 * fq;
#pragma unroll
        for (int ai = 0; ai < 2; ++ai)
#pragma unroll
            for (int m = 0; m < 4; ++m) { bf16_t* rowp = base + (size_t)(row0 + ai * HALF + m * 16) * ldc + col0;
#pragma unroll
                for (int bj = 0; bj < 2; ++bj) { const f32x4 v0 = acc[ai][bj][m][0], v1 = acc[ai][bj][m][1];
                    u32x4 w; w.x = cvtpk(v0[0], v0[1]); w.y = cvtpk(v0[2], v0[3]); w.z = cvtpk(v1[0], v1[1]); w.w = cvtpk(v1[2], v1[3]);
                    *(u32x4*)(rowp + bj * HALF) = w; } }
    }
};
struct EpiKV {
    static constexpr bool PERM = true, AFTER_DRAIN = false;
    bf16_t* Kn; bf16_t* V; const float* g; PG8_LAS float* xl;
    __device__ __forceinline__ void operator()(const f32x4 (&acc)[2][2][4][2], const Unit& u, int wr, int wc, int fr, int fq) const {
        const int row0 = u.pm * BM + wr * 64 + fr; const int colt = u.pn * BM;
        if (colt >= MLAD) {
            const int head0 = (colt - MLAD) >> 7;
            bf16_t* base = V + wc * 32 + 8 * fq;
#pragma unroll
            for (int ai = 0; ai < 2; ++ai)
#pragma unroll
                for (int m = 0; m < 4; ++m) { const size_t r = (size_t)(row0 + ai * HALF + m * 16);
#pragma unroll
                    for (int bj = 0; bj < 2; ++bj) { const f32x4 v0 = acc[ai][bj][m][0], v1 = acc[ai][bj][m][1];
                        u32x4 w; w.x = cvtpk(v0[0], v0[1]); w.y = cvtpk(v0[2], v0[3]); w.z = cvtpk(v1[0], v1[1]); w.w = cvtpk(v1[2], v1[3]);
                        *(u32x4*)(base + ((size_t)(head0 + bj) * KROWS + r) * 128) = w; } }
            return;
        }
        float ss[2][4][2];
#pragma unroll
        for (int ai = 0; ai < 2; ++ai)
#pragma unroll
            for (int m = 0; m < 4; ++m)
#pragma unroll
                for (int bj = 0; bj < 2; ++bj) { const f32x4 v0 = acc[ai][bj][m][0], v1 = acc[ai][bj][m][1];
                    float a = (v0[0] * v0[0] + v0[1] * v0[1]) + (v0[2] * v0[2] + v0[3] * v0[3]) + (v1[0] * v1[0] + v1[1] * v1[1]) + (v1[2] * v1[2] + v1[3] * v1[3]);
                    a += __shfl_xor(a, 16); a += __shfl_xor(a, 32);
                    ss[ai][m][bj] = a; }
        PG8_LAS float* mine = xl + (wr * 4 + wc) * 256;
        if (fq == 0) {
#pragma unroll
            for (int ai = 0; ai < 2; ++ai)
#pragma unroll
                for (int m = 0; m < 4; ++m)
#pragma unroll
                    for (int bj = 0; bj < 2; ++bj) mine[((ai * 4 + m) * 2 + bj) * 16 + fr] = ss[ai][m][bj];
        }
        asm volatile("s_waitcnt lgkmcnt(0)" ::: "memory"); __builtin_amdgcn_s_barrier(); asm volatile("" ::: "memory");
        const int colh = wc * 32 + 8 * fq;
        const f32x4 g0 = *(const f32x4*)(g + colh), g1 = *(const f32x4*)(g + colh + 4);
        const int head0 = colt >> 7;
        bf16_t* base = Kn + colh;
#pragma unroll
        for (int ai = 0; ai < 2; ++ai)
#pragma unroll
            for (int m = 0; m < 4; ++m) { const size_t r = (size_t)(row0 + ai * HALF + m * 16);
#pragma unroll
                for (int bj = 0; bj < 2; ++bj) {
                    const int slot = ((ai * 4 + m) * 2 + bj) * 16 + fr;
                    const float tot = (xl[(wr * 4 + 0) * 256 + slot] + xl[(wr * 4 + 1) * 256 + slot]) + (xl[(wr * 4 + 2) * 256 + slot] + xl[(wr * 4 + 3) * 256 + slot]);
                    const float rs = rsqrtf(tot * (1.f / 128) + NORM_EPS);
                    const f32x4 v0 = acc[ai][bj][m][0] * rs * g0, v1 = acc[ai][bj][m][1] * rs * g1;
                    u32x4 w; w.x = cvtpk(v0[0], v0[1]); w.y = cvtpk(v0[2], v0[3]); w.z = cvtpk(v1[0], v1[1]); w.w = cvtpk(v1[2], v1[3]);
                    *(u32x4*)(base + ((size_t)(head0 + bj) * KROWS + r) * 128) = w; } }
    }
};
struct EpiPart {
    static constexpr bool PERM = false, AFTER_DRAIN = false;
    float* P;
    __device__ __forceinline__ void operator()(const f32x4 (&acc)[2][2][4][2], const Unit&, int wr, int wc, int fr, int fq) const {
        const int col0 = wc * 32 + 4 * fq;
#pragma unroll
        for (int ai = 0; ai < 2; ++ai)
#pragma unroll
            for (int m = 0; m < 4; ++m) { float* prow = P + (size_t)(ai * HALF + wr * 64 + m * 16 + fr) * BM + col0;
#pragma unroll
                for (int bj = 0; bj < 2; ++bj)
#pragma unroll
                    for (int n = 0; n < 2; ++n) *(f32x4*)(prow + bj * HALF + n * 16) = acc[ai][bj][m][n]; }
    }
};
struct EpiResGate {
    static constexpr bool PERM = false, AFTER_DRAIN = false;
    const float* xp; const float* xs; float* out; const float* gate;
    __device__ __forceinline__ void operator()(const f32x4 (&acc)[2][2][4][2], const Unit& u, int wr, int wc, int fr, int fq) const {
        const int col0 = u.pn * BM + wc * 32 + 4 * fq;
#pragma unroll
        for (int ai = 0; ai < 2; ++ai)
#pragma unroll
            for (int mp = 0; mp < 2; ++mp) {
                f32x4 xv8[8], gv8[8];
#pragma unroll
                for (int q = 0; q < 8; ++q) { const int m = 2 * mp + (q >> 2), r = u.pm * BM + ai * HALF + wr * 64 + m * 16 + fr, c = col0 + ((q >> 1) & 1) * HALF + (q & 1) * 16;
                    const int seq = r < MP ? (r >> 12) : 4 + ((r - MP) >> 5);
                    const float* xr = r < MP ? xp + (size_t)r * DM : xs + (size_t)(r - MP) * DM;
                    xv8[q] = *(const f32x4*)(xr + c); gv8[q] = *(const f32x4*)(gate + (size_t)seq * (3 * DM) + c); }
#pragma unroll
                for (int q = 0; q < 8; ++q) { const int m = 2 * mp + (q >> 2), r = u.pm * BM + ai * HALF + wr * 64 + m * 16 + fr, c = col0 + ((q >> 1) & 1) * HALF + (q & 1) * 16;
                    *(f32x4*)(out + (size_t)r * DM + c) = xv8[q] + gv8[q] * acc[ai][(q >> 1) & 1][m][q & 1]; }
            }
    }
};

template <class Epi, class Sched, bool ALIGN_EPI = false, bool SP2 = false>
__device__ __forceinline__ void gemm_phase(PG8_LAS unsigned char* lds, const Gemm g, const Sched& S, const Epi& E) {
    int tid_ = threadIdx.x; asm volatile("" : "+v"(tid_));
    const int tid = tid_, wid = __builtin_amdgcn_readfirstlane(tid >> 6), lane = tid & 63, wr = wid >> 2, wc = wid & 3, fr = lane & 15, fq = lane >> 4;
    const int K = g.K, LD = g.ld ? g.ld : g.K, nt = K / BK;
    unsigned voffA[2], voffB[2];
#pragma unroll
    for (int i = 0; i < 2; ++i) { int R, C; stage_rc(tid * 16 + i * 8192, R, C); const int Rb = Epi::PERM ? ((R & ~31) + perm32(R & 31)) : R;
        voffA[i] = (unsigned)(R * LD + C) * 2u; voffB[i] = (unsigned)(Rb * LD + C) * 2u; }
    const size_t kstep = (size_t)(BK * 2);
    const size_t hstep = (size_t)HALF * LD * 2;
    const size_t tstep = 2 * hstep;
    const unsigned ldsw = (unsigned)wid * 1024u;
    const int aoff = lds_byte(wr * 64 + fr, fq * 8), boff = lds_byte(wc * 32 + fr, fq * 8);
#define PG8_SA(b, h) (((b) * 2 + (h)) * HTB)
#define PG8_SB(b, h) ((4 + (b) * 2 + (h)) * HTB)
#define PG8_STAGE(bufoff, gbase, voff) do { _Pragma("unroll") for (int _i = 0; _i < 2; ++_i) \
        __builtin_amdgcn_global_load_lds((const unsigned*)((const char*)(gbase) + (voff)[_i]), (PG8_LAS unsigned*)(lds + (bufoff) + ldsw + _i * 8192), 16, 0, 0); } while (0)
#define PG8_LDA(dst, b, h) do { _Pragma("unroll") for (int m = 0; m < 4; ++m) _Pragma("unroll") for (int k = 0; k < 2; ++k) dst[m][k] = *(const PG8_LAS bf16x8*)(lds + PG8_SA(b, h) + aoff + m * 2048 + k * 1024); } while (0)
#define PG8_LDB(dst, b, h) do { _Pragma("unroll") for (int n = 0; n < 2; ++n) _Pragma("unroll") for (int k = 0; k < 2; ++k) dst[n][k] = *(const PG8_LAS bf16x8*)(lds + PG8_SB(b, h) + boff + n * 2048 + k * 1024); } while (0)
#define PG8_MMA(ai, bj, At, Bt) do { __builtin_amdgcn_s_setprio(1); _Pragma("unroll") for (int m = 0; m < 4; ++m) _Pragma("unroll") for (int n = 0; n < 2; ++n) _Pragma("unroll") for (int k = 0; k < 2; ++k) \
        acc[ai][bj][m][n] = __builtin_amdgcn_mfma_f32_16x16x32_bf16(Bt[n][k], At[m][k], acc[ai][bj][m][n], 0, 0, 0); __builtin_amdgcn_s_setprio(0); } while (0)
#define PG8_WAIT_V(n) asm volatile("s_waitcnt vmcnt(" #n ")" ::: "memory")
#define PG8_WAIT_L(n) asm volatile("s_waitcnt lgkmcnt(" #n ")" ::: "memory")
#define PG8_BAR __builtin_amdgcn_s_barrier()
#define PG8_SCHED __builtin_amdgcn_sched_barrier(0)
    Unit cur, nxt; int ui = 0;
    if (!S.next(0, cur)) return;
    f32x4 acc[2][2][4][2];
#pragma unroll
    for (int a = 0; a < 2; ++a)
#pragma unroll
        for (int b = 0; b < 2; ++b)
#pragma unroll
            for (int m = 0; m < 4; ++m)
#pragma unroll
                for (int n = 0; n < 2; ++n) acc[a][b][m][n] = (f32x4){0.f, 0.f, 0.f, 0.f};
    bf16x8 At[4][2], B0[2][2], B1[2][2];
    const char* cA = (const char*)g.A + (size_t)cur.pm * tstep; const char* cB = (const char*)g.Bt + (size_t)cur.pn * tstep;
    S.a_ready(cur);
    if constexpr (SP2) {
        PG8_STAGE(PG8_SB(0, 0), cB, voffB); PG8_STAGE(PG8_SB(0, 1), cB + hstep, voffB); PG8_STAGE(PG8_SA(0, 0), cA, voffA); PG8_STAGE(PG8_SA(0, 1), cA + hstep, voffA);
        if (wr == 1) PG8_BAR;
        PG8_WAIT_V(2); PG8_BAR;
        PG8_STAGE(PG8_SB(1, 0), cB + kstep, voffB); PG8_STAGE(PG8_SA(1, 0), cA + kstep, voffA); PG8_STAGE(PG8_SB(1, 1), cB + hstep + kstep, voffB);
        PG8_WAIT_V(6); PG8_BAR;
    } else {
        PG8_STAGE(PG8_SB(0, 0), cB, voffB); PG8_STAGE(PG8_SA(0, 0), cA, voffA); PG8_STAGE(PG8_SB(0, 1), cB + hstep, voffB); PG8_STAGE(PG8_SA(0, 1), cA + hstep, voffA);
        if (wr == 1) PG8_BAR;
        PG8_WAIT_V(4); PG8_BAR;
        PG8_STAGE(PG8_SB(1, 0), cB + kstep, voffB); PG8_STAGE(PG8_SA(1, 0), cA + kstep, voffA); PG8_STAGE(PG8_SB(1, 1), cB + hstep + kstep, voffB);
        PG8_WAIT_V(6); PG8_BAR;
    }
    for (;;) {
        const bool has_next = S.next(ui + 1, nxt);
        const char* nA = has_next ? (const char*)g.A + (size_t)nxt.pm * tstep : cA; const char* nB = has_next ? (const char*)g.Bt + (size_t)nxt.pn * tstep : cB;
        for (int t = 0; t < nt; t += 2) {
            const bool last = (t == nt - 2);
            const char* a1 = cA + (size_t)(t + 1) * kstep;
            const char* a2 = last ? nA : cA + (size_t)(t + 2) * kstep; const char* b2 = last ? nB : cB + (size_t)(t + 2) * kstep;
            const char* a3 = a2 + kstep; const char* b3 = b2 + kstep;
            if (last && has_next) S.a_ready(nxt);
            if constexpr (SP2) {
            PG8_LDB(B0, 0, 0); PG8_LDB(B1, 0, 1); PG8_SCHED; PG8_LDA(At, 0, 0); PG8_STAGE(PG8_SA(1, 1), a1 + hstep, voffA);
            PG8_WAIT_V(8); PG8_WAIT_L(0); PG8_BAR; PG8_MMA(0, 0, At, B0); PG8_MMA(0, 1, At, B1); PG8_BAR; PG8_SCHED;
            PG8_LDA(At, 0, 1); PG8_STAGE(PG8_SB(0, 0), b2, voffB); PG8_STAGE(PG8_SB(0, 1), b2 + hstep, voffB); PG8_STAGE(PG8_SA(0, 0), a2, voffA);
            PG8_WAIT_V(8); PG8_WAIT_L(0); PG8_BAR; PG8_MMA(1, 0, At, B0); PG8_MMA(1, 1, At, B1); PG8_BAR; PG8_SCHED;
            PG8_LDB(B0, 1, 0); PG8_LDB(B1, 1, 1); PG8_SCHED; PG8_LDA(At, 1, 0); PG8_STAGE(PG8_SA(0, 1), a2 + hstep, voffA);
            PG8_WAIT_V(8); PG8_WAIT_L(0); PG8_BAR; PG8_MMA(0, 0, At, B0); PG8_MMA(0, 1, At, B1); PG8_BAR; PG8_SCHED;
            PG8_LDA(At, 1, 1); PG8_STAGE(PG8_SB(1, 0), b3, voffB); PG8_STAGE(PG8_SB(1, 1), b3 + hstep, voffB); PG8_STAGE(PG8_SA(1, 0), a3, voffA);
            PG8_WAIT_V(8); PG8_WAIT_L(0); PG8_BAR; PG8_MMA(1, 0, At, B0); PG8_MMA(1, 1, At, B1); PG8_BAR; PG8_SCHED;
            } else {
            PG8_LDB(B0, 0, 0); PG8_SCHED; PG8_LDA(At, 0, 0); PG8_STAGE(PG8_SA(1, 1), a1 + hstep, voffA);
            PG8_WAIT_L(8); PG8_BAR; PG8_WAIT_L(0); PG8_MMA(0, 0, At, B0); PG8_BAR; PG8_SCHED;
            PG8_LDB(B1, 0, 1); PG8_STAGE(PG8_SB(0, 0), b2, voffB);
            PG8_BAR; PG8_WAIT_L(0); PG8_MMA(0, 1, At, B1); PG8_BAR;
            PG8_LDA(At, 0, 1); PG8_STAGE(PG8_SA(0, 0), a2, voffA);
            PG8_BAR; PG8_WAIT_L(0); PG8_MMA(1, 0, At, B0); PG8_BAR; PG8_SCHED;
            PG8_STAGE(PG8_SB(0, 1), b2 + hstep, voffB);
            PG8_WAIT_V(6); PG8_BAR; PG8_MMA(1, 1, At, B1); PG8_BAR;
            PG8_LDB(B0, 1, 0); PG8_SCHED; PG8_LDA(At, 1, 0); PG8_STAGE(PG8_SA(0, 1), a2 + hstep, voffA);
            PG8_WAIT_L(8); PG8_BAR; PG8_WAIT_L(0); PG8_MMA(0, 0, At, B0); PG8_BAR; PG8_SCHED;
            PG8_LDB(B1, 1, 1); PG8_STAGE(PG8_SB(1, 0), b3, voffB);
            PG8_BAR; PG8_WAIT_L(0); PG8_MMA(0, 1, At, B1); PG8_BAR;
            PG8_LDA(At, 1, 1); PG8_STAGE(PG8_SA(1, 0), a3, voffA);
            PG8_BAR; PG8_WAIT_L(0); PG8_MMA(1, 0, At, B0); PG8_BAR; PG8_SCHED;
            PG8_STAGE(PG8_SB(1, 1), b3 + hstep, voffB);
            PG8_WAIT_V(6); PG8_BAR; PG8_MMA(1, 1, At, B1); PG8_BAR;
            }
        }
        if constexpr (ALIGN_EPI) { if (wr == 0) PG8_BAR; }
        if constexpr (!Epi::AFTER_DRAIN) { E(acc, cur, wr, wc, fr, fq); S.done(cur); }
        if (!has_next) break;
#pragma unroll
        for (int a = 0; a < 2; ++a)
#pragma unroll
            for (int b = 0; b < 2; ++b)
#pragma unroll
                for (int m = 0; m < 4; ++m)
#pragma unroll
                    for (int n = 0; n < 2; ++n) acc[a][b][m][n] = (f32x4){0.f, 0.f, 0.f, 0.f};
        cur = nxt; cA = nA; cB = nB; ++ui;
        if constexpr (ALIGN_EPI) { if (wr == 1) PG8_BAR; }
    }
    PG8_WAIT_V(0);
    if constexpr (!ALIGN_EPI) { if (wr == 0) PG8_BAR; }
    PG8_BAR;
#undef PG8_SA
#undef PG8_SB
#undef PG8_STAGE
#undef PG8_LDA
#undef PG8_LDB
#undef PG8_MMA
#undef PG8_WAIT_V
#undef PG8_WAIT_L
#undef PG8_BAR
#undef PG8_SCHED
}
}

#define XB_TMO      128
#define XB_XCNT(j)  (256  + 64 * (j))
#define XB_XSUB(j)  (1280 + 64 * (j))
#define XB_XGEN(j)  (2304 + 64 * (j))
#define XB_TOP      3328
#define XB_TOPGEN   3392
#define XCD_BAR_WORDS 3456
#define XB_SPIN_CAP (1u << 18)
__device__ __forceinline__ unsigned xb_ld(unsigned* p)              { return __hip_atomic_load(p, __ATOMIC_RELAXED, __HIP_MEMORY_SCOPE_AGENT); }
__device__ __forceinline__ unsigned xb_add(unsigned* p, unsigned v) { return __hip_atomic_fetch_add(p, v, __ATOMIC_RELAXED, __HIP_MEMORY_SCOPE_AGENT); }
__device__ __forceinline__ unsigned xb_xcc_id() { return (unsigned)__builtin_amdgcn_s_getreg((3 << 11) | 20) & 0xFu; }
#define XB_SPIN(cond, bar) do { unsigned _sp = 0; while (cond) { __builtin_amdgcn_s_sleep(1); \
    if ((++_sp & 255u) == 0u) { if (xb_ld(&(bar)[XB_TMO])) break; if (_sp > XB_SPIN_CAP) { atomicAdd(&(bar)[XB_TMO], 1u); break; } } } } while (0)
struct XcdBarrier { unsigned* bar; unsigned x; volatile LAS unsigned* st; };
__device__ __forceinline__ XcdBarrier xcd_barrier_post(unsigned* bar, volatile LAS unsigned* st) {
    XcdBarrier b; b.bar = bar; b.x = xb_xcc_id(); b.st = st;
    if (threadIdx.x == 0) (void)xb_add(&bar[XB_XCNT(b.x)], 1u);
    return b;
}
__device__ __forceinline__ void xcd_barrier_complete(unsigned* bar, unsigned x, unsigned& nloc, unsigned& nx) {
    const unsigned G = gridDim.x * gridDim.y * gridDim.z;
    unsigned sum, cnt, mine, sp = 0u;
    for (;;) {
        sum = 0u; cnt = 0u; mine = 0u;
#pragma unroll
        for (unsigned j = 0; j < 16; ++j) { const unsigned c = xb_ld(&bar[XB_XCNT(j)]); sum += c; cnt += (c > 0u) ? 1u : 0u; mine = (j == x) ? c : mine; }
        if (sum == G) break;
        __builtin_amdgcn_s_sleep(1);
        if ((++sp & 255u) == 0u) { if (xb_ld(&bar[XB_TMO])) break; if (sp > XB_SPIN_CAP) { atomicAdd(&bar[XB_TMO], 1u); break; } }
    }
    nloc = mine > 0u ? mine : 1u; nx = cnt > 0u ? cnt : 1u;
}
__device__ __forceinline__ void xcd_barrier(const XcdBarrier& b) {
    asm volatile("s_waitcnt vmcnt(0)" ::: "memory");
    __syncthreads();
    if (threadIdx.x == 0) {
        unsigned* bar = b.bar;
        __builtin_amdgcn_s_waitcnt(0);
        unsigned nloc = b.st[0], nx = b.st[1];
        if (nloc == 0u) { xcd_barrier_complete(bar, b.x, nloc, nx); b.st[0] = nloc; b.st[1] = nx; }
        const unsigned old = xb_add(&bar[XB_XSUB(b.x)], 1u);
        const unsigned gen = old / nloc;
        if (old + 1u == (gen + 1u) * nloc) {
            __builtin_amdgcn_fence(__ATOMIC_RELEASE, "agent");
            asm volatile("s_waitcnt vmcnt(0)" ::: "memory");
            const unsigned og = xb_add(&bar[XB_TOP], 1u);
            const unsigned tg = og / nx;
            if (og + 1u == (tg + 1u) * nx) xb_add(&bar[XB_TOPGEN], 1u);
            else XB_SPIN(xb_ld(&bar[XB_TOPGEN]) == tg, bar);
            __builtin_amdgcn_fence(__ATOMIC_ACQUIRE, "agent");
            xb_add(&bar[XB_XGEN(b.x)], 1u);
            asm volatile("s_waitcnt vmcnt(0)" ::: "memory");
        } else {
            XB_SPIN(xb_ld(&bar[XB_XGEN(b.x)]) == gen, bar);
            __builtin_amdgcn_fence(__ATOMIC_ACQUIRE, "agent");
            asm volatile("s_waitcnt vmcnt(0)" ::: "memory");
        }
    }
    __syncthreads();
}

namespace att {
constexpr int SHM_V = 16384, SHM_KN = 16384, SHM_KR = 8192, KSTRIDE = SHM_KN + SHM_KR;
constexpr int OFF_V = 0, OFF_K = 2 * SHM_V, OFF_WS = OFF_K + 2 * KSTRIDE, LDS_BYTES = OFF_WS + 8 * 64 * 4;
#define KSWZ(row, colB) ((row) * 256 + ((colB) ^ (((row) & 15) << 4)))
#define KRSWZ(row, colB) ((row) * 128 + ((colB) ^ ((((row) >> 1) & 7) << 4)))
#define SBAR() __builtin_amdgcn_sched_barrier(0)
__device__ __forceinline__ int v_st(int k, int c) { const int kk = (k & ~0xC) | ((k & 4) << 1) | ((k & 8) >> 1); return ((kk >> 3) * 4 + (c >> 5)) * 512 + ((kk & 7) * 32 + (c & 31)) * 2; }
__device__ __forceinline__ int v_rd_base(int lane) { return ((lane & 3) << 3) | (((lane >> 2) & 3) << 6) | (((lane >> 4) & 1) << 5) | (((lane >> 5) & 1) << 8); }
constexpr int v_rd_off(int d0, int ks, int half) { return d0 * 512 + ks * 4096 + half * 2048; }
__device__ __forceinline__ int crow(int r, int hi) { return (r & 3) + 8 * (r >> 2) + 4 * hi; }

struct AUnit { const bf16_t* Q; const bf16_t* Kn; const bf16_t* V; const bf16_t* Kr; bf16_t* O; int nt, nwav, jbase, lastmask; int pos0; const float* gqn; const float* gqr; const float2* tab; };

template <int KB>
__device__ __forceinline__ void qkt(f32x16& p0, f32x16& p1, LAS const char* lds, int r32, int hi, const bf16x8* qr) {
    p0 = f32x16{}; p1 = f32x16{};
    LAS const char* kn = lds + OFF_K + KB * KSTRIDE;
    LAS const char* kr = kn + SHM_KN;
#pragma unroll
    for (int d0 = 0; d0 < 8; ++d0) {
        LAS const char* a = kn + KSWZ(r32, (d0 * 16 + hi * 8) * 2);
        const bf16x8 b0 = *(LAS const bf16x8*)a;
        const bf16x8 b1 = *(LAS const bf16x8*)(a + 32 * 256);
        p0 = __builtin_amdgcn_mfma_f32_32x32x16_bf16(b0, qr[d0], p0, 0, 0, 0);
        p1 = __builtin_amdgcn_mfma_f32_32x32x16_bf16(b1, qr[d0], p1, 0, 0, 0);
    }
#pragma unroll
    for (int d0 = 0; d0 < 4; ++d0) {
        LAS const char* a = kr + KRSWZ(r32, (d0 * 16 + hi * 8) * 2);
        const bf16x8 b0 = *(LAS const bf16x8*)a;
        const bf16x8 b1 = *(LAS const bf16x8*)(a + 32 * 128);
        p0 = __builtin_amdgcn_mfma_f32_32x32x16_bf16(b0, qr[8 + d0], p0, 0, 0, 0);
        p1 = __builtin_amdgcn_mfma_f32_32x32x16_bf16(b1, qr[8 + d0], p1, 0, 0, 0);
    }
}
template <int VB>
__device__ __forceinline__ void pv_tile(f32x16* o, int vb0, bf16x8 pa0, bf16x8 pa1, bf16x8 pa2, bf16x8 pa3) {
#define TRRD(dst, off) asm volatile("ds_read_b64_tr_b16 %0, %1 offset:%2" : "=&v"(dst) : "v"(vb0), "i"(off) : "memory")
#define PV_D0(d0) do { s16x4 l0, l1, l2, l3, h0, h1, h2, h3; constexpr int b_ = OFF_V + VB * SHM_V + v_rd_off(d0, 0, 0); \
        TRRD(l0, b_); TRRD(h0, b_ + 2048); TRRD(l1, b_ + 4096); TRRD(h1, b_ + 6144); TRRD(l2, b_ + 8192); TRRD(h2, b_ + 10240); TRRD(l3, b_ + 12288); TRRD(h3, b_ + 14336); \
        asm volatile("s_waitcnt lgkmcnt(0)" ::: "memory"); SBAR(); \
        o[d0] = __builtin_amdgcn_mfma_f32_32x32x16_bf16(pa0, (bf16x8){l0[0], l0[1], l0[2], l0[3], h0[0], h0[1], h0[2], h0[3]}, o[d0], 0, 0, 0);   \
        o[d0] = __builtin_amdgcn_mfma_f32_32x32x16_bf16(pa1, (bf16x8){l1[0], l1[1], l1[2], l1[3], h1[0], h1[1], h1[2], h1[3]}, o[d0], 0, 0, 0);   \
        o[d0] = __builtin_amdgcn_mfma_f32_32x32x16_bf16(pa2, (bf16x8){l2[0], l2[1], l2[2], l2[3], h2[0], h2[1], h2[2], h2[3]}, o[d0], 0, 0, 0);   \
        o[d0] = __builtin_amdgcn_mfma_f32_32x32x16_bf16(pa3, (bf16x8){l3[0], l3[1], l3[2], l3[3], h3[0], h3[1], h3[2], h3[3]}, o[d0], 0, 0, 0); } while (0)
    PV_D0(0); PV_D0(1); PV_D0(2); PV_D0(3);
#undef PV_D0
#undef TRRD
}

template <int VAR>
__device__ __forceinline__ void attn_unit(const AUnit& u, LAS char* lds) {
    int tid_ = threadIdx.x; asm volatile("" : "+v"(tid_));
    const int tid = tid_, wid = __builtin_amdgcn_readfirstlane(tid >> 6), lane = tid & 63, r32 = lane & 31, hi = lane >> 5;
    const bool wact = wid < u.nwav;
    const int jmax = u.jbase + (wid >> 1);
    const bf16_t* gk0; const bf16_t* gk1; const bf16_t* gkr; const bf16_t* gv0; const bf16_t* gv1;
    {
        const int rk0 = (2 * wid) * 4 + (lane >> 4), rk1 = rk0 + 4, ph = lane & 15;
        gk0 = u.Kn + (size_t)rk0 * 128 + ((ph ^ (rk0 & 15)) * 8);
        gk1 = u.Kn + (size_t)rk1 * 128 + ((ph ^ (rk1 & 15)) * 8);
        const int rr0 = wid * 8 + (lane >> 3), pr = lane & 7;
        gkr = u.Kr + (size_t)rr0 * ROPE + ((pr ^ ((rr0 >> 1) & 7)) * 8);
#pragma unroll
        for (int i = 0; i < 2; ++i) {
            const int st = (2 * wid + i) * 2 + (lane >> 5), o16 = lane & 31, kk = (st >> 2) * 8 + (o16 >> 2), c = (st & 3) * 32 + (o16 & 3) * 8;
            const int key = (kk & ~0xC) | ((kk & 4) << 1) | ((kk & 8) >> 1);
            const bf16_t* p = u.V + (size_t)key * 128 + c;
            if (i == 0) gv0 = p; else gv1 = p;
        }
    }
#define ADMA(t, bf) do { const size_t ro = (size_t)(t) * 64; LAS char* kb_ = lds + OFF_K + (bf) * KSTRIDE; LAS char* vb_ = lds + OFF_V + (bf) * SHM_V; \
        __builtin_amdgcn_global_load_lds((const unsigned*)(gk0 + ro * 128), (LAS unsigned*)(kb_ + (2 * wid) * 1024), 16, 0, 0); \
        __builtin_amdgcn_global_load_lds((const unsigned*)(gk1 + ro * 128), (LAS unsigned*)(kb_ + (2 * wid + 1) * 1024), 16, 0, 0); \
        __builtin_amdgcn_global_load_lds((const unsigned*)(gkr + ro * ROPE), (LAS unsigned*)(kb_ + SHM_KN + wid * 1024), 16, 0, 0); \
        __builtin_amdgcn_global_load_lds((const unsigned*)(gv0 + ro * 128), (LAS unsigned*)(vb_ + (2 * wid) * 1024), 16, 0, 0); \
        __builtin_amdgcn_global_load_lds((const unsigned*)(gv1 + ro * 128), (LAS unsigned*)(vb_ + (2 * wid + 1) * 1024), 16, 0, 0); } while (0)
#define AWAITV() asm volatile("s_waitcnt vmcnt(0)" ::: "memory")
    ADMA(0, 0);
    bf16x8 qr[12];
    {
        const int wq = wact ? wid : 0;
        const bf16_t* qp = u.Q + (size_t)(wq * 32 + r32) * QW + hi * 8;
#pragma unroll
        for (int d0 = 0; d0 < 12; ++d0) qr[d0] = *(const bf16x8*)(qp + d0 * 16);
        float ssn = 0.f, ssr = 0.f;
#pragma unroll
        for (int d0 = 0; d0 < 12; ++d0) { float f[8]; unpack8(__builtin_bit_cast(u32x4, qr[d0]), f); float a = 0.f;
#pragma unroll
            for (int e = 0; e < 8; ++e) a += f[e] * f[e];
            if (d0 < 8) ssn += a; else ssr += a; }
        { auto rr = __builtin_amdgcn_permlane32_swap(__float_as_uint(ssn), __float_as_uint(ssn), false, false); ssn = __uint_as_float(rr[0]) + __uint_as_float(rr[1]); }
        { auto rr = __builtin_amdgcn_permlane32_swap(__float_as_uint(ssr), __float_as_uint(ssr), false, false); ssr = __uint_as_float(rr[0]) + __uint_as_float(rr[1]); }
        const float rn = rsqrtf(ssn * (1.f / 128) + NORM_EPS) * QSCALE, rr_ = rsqrtf(ssr * (1.f / ROPE) + NORM_EPS);
#pragma unroll
        for (int d0 = 0; d0 < 8; ++d0) { float f[8]; unpack8(__builtin_bit_cast(u32x4, qr[d0]), f);
            const f32x4 g0 = *(const f32x4*)(u.gqn + d0 * 16 + hi * 8), g1 = *(const f32x4*)(u.gqn + d0 * 16 + hi * 8 + 4);
#pragma unroll
            for (int e = 0; e < 4; ++e) { f[e] *= rn * g0[e]; f[4 + e] *= rn * g1[e]; }
            qr[d0] = __builtin_bit_cast(bf16x8, pack8(f)); }
        const int pos = u.pos0 + wq * 32 + r32;
#pragma unroll
        for (int a = 0; a < 2; ++a) { float x1[8], x2[8]; unpack8(__builtin_bit_cast(u32x4, qr[8 + a]), x1); unpack8(__builtin_bit_cast(u32x4, qr[10 + a]), x2);
            const int i0 = a * 16 + hi * 8;
            const f32x4 ga0 = *(const f32x4*)(u.gqr + i0), ga1 = *(const f32x4*)(u.gqr + i0 + 4), gb0 = *(const f32x4*)(u.gqr + 32 + i0), gb1 = *(const f32x4*)(u.gqr + 32 + i0 + 4);
            float y1[8], y2[8];
#pragma unroll
            for (int e = 0; e < 8; ++e) { const float v1 = x1[e] * rr_ * (e < 4 ? ga0[e & 3] : ga1[e & 3]), v2 = x2[e] * rr_ * (e < 4 ? gb0[e & 3] : gb1[e & 3]);
                const float2 cs = u.tab[pos * 32 + i0 + e];
                y1[e] = (v1 * cs.x - v2 * cs.y) * QSCALE; y2[e] = (v2 * cs.x + v1 * cs.y) * QSCALE; }
            qr[8 + a] = __builtin_bit_cast(bf16x8, pack8(y1)); qr[10 + a] = __builtin_bit_cast(bf16x8, pack8(y2)); }
    }
    float m_reg = -1e30f, l_reg = 0.f; f32x16 o[4]; o[0] = f32x16{}; o[1] = f32x16{}; o[2] = f32x16{}; o[3] = f32x16{};
    LAS float* wsf = (LAS float*)(lds + OFF_WS) + wid * 64; LAS float* li_l = wsf; LAS float* al_l = wsf + 32;
    const int vb0 = (int)(unsigned)(uintptr_t)lds + v_rd_base(lane);
    AWAITV();
    __syncthreads();
#define ASTEP(BF, j) do { const int j_ = (j); const bool more_ = (VAR != 2) && (j_ + 1 < u.nt); \
        if (more_) ADMA(j_ + 1, (BF) ^ 1); \
        if (wact && j_ <= jmax) { \
            f32x16 p0, p1; if (VAR == 3) { _Pragma("unroll") for (int r = 0; r < 16; ++r) { p0[r] = (float)(r + j_) * 0.01f; p1[r] = (float)(r32 + r) * 0.01f; } } else qkt<BF>(p0, p1, lds, r32, hi, qr); \
            if (u.lastmask && j_ == u.nt - 1) { _Pragma("unroll") for (int r = 0; r < 16; ++r) p1[r] = -__builtin_inff(); } \
            if (VAR != 1) { \
            float pmax = p0[0]; _Pragma("unroll") for (int r = 1; r < 16; ++r) pmax = fmaxf(pmax, p0[r]); _Pragma("unroll") for (int r = 0; r < 16; ++r) pmax = fmaxf(pmax, p1[r]); \
            { auto rr = __builtin_amdgcn_permlane32_swap(__float_as_uint(pmax), __float_as_uint(pmax), false, false); pmax = fmaxf(__uint_as_float(rr[0]), __uint_as_float(rr[1])); } \
            const float mn = fmaxf(m_reg, pmax); const float alpha = __builtin_amdgcn_exp2f(m_reg - mn); m_reg = mn; \
            _Pragma("unroll") for (int r = 0; r < 16; ++r) { p0[r] = __builtin_amdgcn_exp2f(p0[r] - mn); p1[r] = __builtin_amdgcn_exp2f(p1[r] - mn); } \
            float ps = 0.f; _Pragma("unroll") for (int r = 0; r < 16; ++r) ps += p0[r]; _Pragma("unroll") for (int r = 0; r < 16; ++r) ps += p1[r]; \
            { auto rr = __builtin_amdgcn_permlane32_swap(__float_as_uint(ps), __float_as_uint(ps), false, false); ps = __uint_as_float(rr[0]) + __uint_as_float(rr[1]); } \
            l_reg = l_reg * alpha + ps; \
            if (__any(alpha < 1.f)) { if (hi == 0) al_l[r32] = alpha; asm volatile("s_waitcnt lgkmcnt(0)" ::: "memory"); \
                _Pragma("unroll") for (int d_ = 0; d_ < 4; ++d_) _Pragma("unroll") for (int r = 0; r < 16; ++r) o[d_][r] *= al_l[crow(r, hi)]; } \
            } \
            bf16x8 pa0, pa1, pa2, pa3; \
            APK4(p0, 0, pa0); APK4(p0, 8, pa1); APK4(p1, 0, pa2); APK4(p1, 8, pa3); \
            SBAR(); pv_tile<BF>(o, vb0, pa0, pa1, pa2, pa3); } \
        if (more_) { AWAITV(); } \
        __syncthreads(); } while (0)
#define APK4(P, B_, OUT) do { unsigned a0 = cvtpk(P[B_+0], P[B_+1]), a1 = cvtpk(P[B_+2], P[B_+3]); \
        unsigned b0 = cvtpk(P[B_+4], P[B_+5]), b1 = cvtpk(P[B_+6], P[B_+7]); \
        auto r0 = __builtin_amdgcn_permlane32_swap(a0, b0, false, false); auto r1 = __builtin_amdgcn_permlane32_swap(a1, b1, false, false); \
        u32x4 w = {r0[0], r1[0], r0[1], r1[1]}; OUT = __builtin_bit_cast(bf16x8, w); } while (0)
    for (int j = 0; j < u.nt; j += 2) {
        ASTEP(0, j);
        if (j + 1 < u.nt) ASTEP(1, j + 1);
    }
    if (wact) {
        if (hi == 0) li_l[r32] = l_reg;
        asm volatile("s_waitcnt lgkmcnt(0)" ::: "memory");
        float rli[16];
#pragma unroll
        for (int r = 0; r < 16; ++r) rli[r] = __builtin_amdgcn_rcpf(li_l[crow(r, hi)]);
        bf16_t* Ow = u.O + (size_t)(wid * 32) * DM;
        const bool ev = (r32 & 1) == 0;
        unsigned gg[16][4];
        if (ev) {
#pragma unroll
            for (int r = 0; r < 16; ++r)
#pragma unroll
                for (int d0 = 0; d0 < 4; ++d0) gg[r][d0] = *(const unsigned*)(Ow + (size_t)crow(r, hi) * DM + d0 * 32 + r32);
        }
#pragma unroll
        for (int r = 0; r < 16; ++r) { const int orow = crow(r, hi);
#pragma unroll
            for (int d0 = 0; d0 < 4; ++d0) { const float v = o[d0][r] * rli[r]; const float vn = __shfl_xor(v, 1);
                if (ev) { unsigned* p = (unsigned*)(Ow + (size_t)orow * DM + d0 * 32 + r32); const unsigned g = gg[r][d0]; *p = cvtpk(v * bflo(g), vn * bfhi(g)); } } }
    }
#undef ADMA
#undef AWAITV
#undef ASTEP
#undef APK4
}
#undef SBAR
}


namespace chk {
constexpr int CHKB = 15360;
constexpr int O_GA = 0, O_RA = 8192, O_HA = 10240, O_MA = 12288, O_VB = 12800, O_P = 14848;
typedef __bf16 cbf16x2 __attribute__((ext_vector_type(2)));
__device__ __forceinline__ unsigned cpk(float lo, float hi) { const f32x2 v = {lo, hi}; const cbf16x2 b = __builtin_convertvector(v, cbf16x2); return __builtin_bit_cast(unsigned, b); }
__device__ __forceinline__ bf16_t cbf(float f) { return (bf16_t)(cpk(f, 0.f) & 0xffffu); }
__device__ __forceinline__ u32x4 cpack8(const float* f) { u32x4 w; w.x = cpk(f[0], f[1]); w.y = cpk(f[2], f[3]); w.z = cpk(f[4], f[5]); w.w = cpk(f[6], f[7]); return w; }
__device__ __forceinline__ s16x4 pack4(const f32x4& a) { u32x2 w; w.x = cpk(a.x, a.y); w.y = cpk(a.z, a.w); return __builtin_bit_cast(s16x4, w); }
__device__ __forceinline__ bf16x8 pack8(const f32x4& a, const f32x4& b) { u32x4 w; w.x = cpk(a.x, a.y); w.y = cpk(a.z, a.w); w.z = cpk(b.x, b.y); w.w = cpk(b.z, b.w); return __builtin_bit_cast(bf16x8, w); }
__device__ __forceinline__ f32x4 mm32(bf16x8 a, bf16x8 b, f32x4 c) { f32x4 d = __builtin_amdgcn_mfma_f32_16x16x32_bf16(a, b, c, 0, 0, 0); asm volatile("" : "+v"(d) : "v"(a), "v"(b)); return d; }
__device__ __forceinline__ f32x4 mm16(s16x4 a, s16x4 b, f32x4 c) { f32x4 d = __builtin_amdgcn_mfma_f32_16x16x16bf16_1k(a, b, c, 0, 0, 0); asm volatile("" : "+v"(d) : "v"(a), "v"(b)); return d; }
#define CHK_LW() asm volatile("s_waitcnt lgkmcnt(0)" ::: "memory")

struct Raw { float w[16], kk[16], b[16], r[16], k[16], v[16]; };
__device__ __forceinline__ void raw_load(Raw& x, const char* rec, int lane) {
    const int fr = lane & 15, fq = lane >> 4;
#pragma unroll
    for (int t = 0; t < 16; ++t) {
        const float* rp = (const float*)(rec + (size_t)t * REC) + lane; const bf16_t* hp = (const bf16_t*)(rec + (size_t)t * REC + 768) + lane;
        x.w[t] = rp[0]; x.kk[t] = rp[64]; x.b[t] = rp[128]; x.r[t] = bf2f(hp[0]); x.k[t] = bf2f(hp[64]);
    }
#pragma unroll
    for (int vt = 0; vt < 4; ++vt)
#pragma unroll
        for (int e = 0; e < 4; ++e) x.v[vt * 4 + e] = bf2f(*(const bf16_t*)(rec + (size_t)(4 * fq + e) * REC + 1024 + (16 * vt + fr) * 2));
}
__device__ __forceinline__ void precompute(const char* rec, char* out, LAS char* wl, int lane) {
    const int fr = lane & 15, fq = lane >> 4;
    Raw x; raw_load(x, rec, lane);
    const f32x4 zero4 = (f32x4){0.f, 0.f, 0.f, 0.f};
    float At[16], Rt[16], Bt[16], Kt[16];
    float P = 1.f;
#pragma unroll
    for (int t = 0; t < 16; ++t) {
        const float Pm1 = P; P *= x.w[t]; const float ip = __builtin_amdgcn_rcpf(P);
        At[t] = -x.kk[t] * Pm1; Rt[t] = x.r[t] * P; Bt[t] = x.b[t] * ip; Kt[t] = x.k[t] * ip;
    }
    const float P15 = P;
#pragma unroll
    for (int vt = 0; vt < 4; ++vt) *(s16x4*)(out + O_VB + vt * 512 + lane * 8) = pack4((f32x4){x.v[vt * 4 + 0], x.v[vt * 4 + 1], x.v[vt * 4 + 2], x.v[vt * 4 + 3]});
    *(float*)(out + O_P + lane * 4) = P15;
    {
        LAS bf16_t* X = (LAS bf16_t*)wl;
#pragma unroll
        for (int t = 0; t < 16; ++t) {
            const int idx = t * 64 + ((((lane >> 3) ^ ((t >> 1) & 7))) << 3) + (lane & 7);
            const bf16_t bh = cbf(Bt[t]), ah = cbf(At[t]);
            X[idx] = bh; X[1024 + idx] = cbf(Bt[t] - bf2f(bh)); X[2048 + idx] = ah; X[3072 + idx] = cbf(At[t] - bf2f(ah)); X[4096 + idx] = cbf(Kt[t]); X[5120 + idx] = cbf(Rt[t]);
        }
        float bc[16];
#pragma unroll
        for (int t = 0; t < 16; ++t) bc[t] = Bt[t] * P15;
        LAS u32x4* at_t = (LAS u32x4*)(wl + 12288 + lane * 32); LAS u32x4* bc_t = (LAS u32x4*)(wl + 14336 + lane * 32);
        at_t[0] = cpack8(At); at_t[1] = cpack8(At + 8); bc_t[0] = cpack8(bc); bc_t[1] = cpack8(bc + 8);
    }
    CHK_LW();
    f32x4 Nc = zero4, Makc = zero4, Mrbc = zero4, Mrkc = zero4;
    {
#pragma unroll
        for (int s2 = 0; s2 < 2; ++s2) {
            const int off = fr * 128 + (((fq + 4 * s2) ^ ((fr >> 1) & 7)) << 4);
            const bf16x8 bh = *(LAS const bf16x8*)(wl + off), bl = *(LAS const bf16x8*)(wl + 2048 + off), ah = *(LAS const bf16x8*)(wl + 4096 + off), al = *(LAS const bf16x8*)(wl + 6144 + off);
            const bf16x8 kh = *(LAS const bf16x8*)(wl + 8192 + off), rh = *(LAS const bf16x8*)(wl + 10240 + off);
            Nc = mm32(bh, ah, Nc); Nc = mm32(bh, al, Nc); Nc = mm32(bl, ah, Nc);
            Makc = mm32(kh, ah, Makc); Mrbc = mm32(bh, rh, Mrbc); Mrkc = mm32(kh, rh, Mrkc);
        }
#pragma unroll
        for (int j = 0; j < 4; ++j) { const int i = 4 * fq + j; if (!(i < fr)) { Nc[j] = 0.f; Makc[j] = 0.f; } if (!(i <= fr)) { Mrbc[j] = 0.f; Mrkc[j] = 0.f; } }
    }
    CHK_LW();
    {
        LAS float* NS = (LAS float*)wl; LAS bf16_t* MAK = (LAS bf16_t*)(wl + 1536);
#pragma unroll
        for (int j = 0; j < 4; ++j) { NS[(4 * fq + j) * 16 + fr] = Nc[j]; MAK[(4 * fq + j) * 16 + fr] = cbf(Makc[j]); }
        CHK_LW();
        float T[16];
#pragma unroll
        for (int i = 15; i >= 0; --i) {
            float acc = 0.f;
#pragma unroll
            for (int q4 = (i + 1) / 4; q4 < 4; ++q4) { const f32x4 nv = *(LAS const f32x4*)(NS + i * 16 + q4 * 4);
#pragma unroll
                for (int e = 0; e < 4; ++e) { const int jj = q4 * 4 + e; if (jj > i) acc += nv[e] * T[jj]; } }
            T[i] = (i == fr) ? 1.f : ((i < fr) ? acc : 0.f);
        }
        LAS u32x4* tt = (LAS u32x4*)(wl + 1024 + fr * 32);
        tt[0] = cpack8(T); tt[1] = cpack8(T + 8);
    }
    CHK_LW();
#define CHK_A16(base, rowb) (*(LAS const s16x4*)(wl + (base) + ((rowb) + fr) * 32 + fq * 8))
    const s16x4 TTf = CHK_A16(1024, 0);
    {
        LAS bf16_t* AH = (LAS bf16_t*)(wl + 2560); LAS bf16_t* MAKP = (LAS bf16_t*)(wl + 2048);
        f32x4 ahc[4];
#pragma unroll
        for (int mk = 0; mk < 4; ++mk) ahc[mk] = mm16(CHK_A16(12288, 16 * mk), TTf, zero4);
        const f32x4 makp = mm16(CHK_A16(1536, 0), TTf, zero4);
#pragma unroll
        for (int mk = 0; mk < 4; ++mk)
#pragma unroll
            for (int j = 0; j < 4; ++j) AH[(16 * mk + 4 * fq + j) * 16 + fr] = cbf(ahc[mk][j]);
#pragma unroll
        for (int j = 0; j < 4; ++j) MAKP[(4 * fq + j) * 16 + fr] = cbf(makp[j]);
        float kc[16];
#pragma unroll
        for (int t = 0; t < 16; ++t) kc[t] = Kt[t] * P15;
        LAS u32x4* rt_t = (LAS u32x4*)(wl + 4608 + lane * 32); LAS u32x4* kc_t = (LAS u32x4*)(wl + 6656 + lane * 32);
        rt_t[0] = cpack8(Rt); rt_t[1] = cpack8(Rt + 8); kc_t[0] = cpack8(kc); kc_t[1] = cpack8(kc + 8);
    }
    CHK_LW();
    const s16x4 Mrb_b = pack4(Mrbc);
    s16x4 Ident;
#pragma unroll
    for (int e = 0; e < 4; ++e) Ident[e] = (4 * fq + e == fr) ? (short)0x3F80 : (short)0;
    {
        f32x4 rh[4];
#pragma unroll
        for (int mk = 0; mk < 4; ++mk) { f32x4 d = mm16(CHK_A16(2560, 16 * mk), Mrb_b, zero4); rh[mk] = mm16(CHK_A16(4608, 16 * mk), Ident, d); }
        *(bf16x8*)(out + O_RA + lane * 16) = pack8(rh[0], rh[1]);
        *(bf16x8*)(out + O_RA + 1024 + lane * 16) = pack8(rh[2], rh[3]);
    }
    { const f32x4 mo = mm16(CHK_A16(2048, 0), Mrb_b, Mrkc); *(s16x4*)(out + O_MA + lane * 8) = pack4(mo); }
#pragma unroll
    for (int nk = 0; nk < 4; ++nk) {
        const s16x4 bcf = CHK_A16(14336, 16 * nk);
        f32x4 gc[4];
#pragma unroll
        for (int mk = 0; mk < 4; ++mk) gc[mk] = mm16(CHK_A16(2560, 16 * mk), bcf, zero4);
        *(bf16x8*)(out + O_GA + (nk * 2 + 0) * 1024 + lane * 16) = pack8(gc[0], gc[1]);
        *(bf16x8*)(out + O_GA + (nk * 2 + 1) * 1024 + lane * 16) = pack8(gc[2], gc[3]);
        f32x4 hc = mm16(CHK_A16(2048, 0), bcf, zero4); hc = mm16(Ident, CHK_A16(6656, 16 * nk), hc);
        *(s16x4*)(out + O_HA + nk * 512 + lane * 8) = pack4(hc);
    }
    CHK_LW();
#undef CHK_A16
}

struct Ops { bf16x8 ga[4][2]; bf16x8 ra[2]; s16x4 ha[4]; s16x4 ma, vb; f32x4 p[4]; };
__device__ __forceinline__ void load_ops(Ops& o, const char* c, int vt, int lane) {
    const int fq = lane >> 4;
#pragma unroll
    for (int mt = 0; mt < 4; ++mt) {
#pragma unroll
        for (int s2 = 0; s2 < 2; ++s2) o.ga[mt][s2] = *(const bf16x8*)(c + O_GA + (mt * 2 + s2) * 1024 + lane * 16);
        o.ha[mt] = *(const s16x4*)(c + O_HA + mt * 512 + lane * 8);
        o.p[mt] = *(const f32x4*)(c + O_P + (16 * mt + 4 * fq) * 4);
    }
    o.ra[0] = *(const bf16x8*)(c + O_RA + lane * 16); o.ra[1] = *(const bf16x8*)(c + O_RA + 1024 + lane * 16);
    o.ma = *(const s16x4*)(c + O_MA + lane * 8); o.vb = *(const s16x4*)(c + O_VB + vt * 512 + lane * 8);
}
__device__ __forceinline__ void step(f32x4 (&Z)[4], const Ops& o, float* orow  , int fq) {
    const bf16x8 bz0 = pack8(Z[0], Z[1]), bz1 = pack8(Z[2], Z[3]);
    f32x4 ot = mm32(o.ra[0], bz0, (f32x4){0.f, 0.f, 0.f, 0.f});
    f32x4 zn[4];
#pragma unroll
    for (int mt = 0; mt < 4; ++mt) zn[mt] = mm32(o.ga[mt][0], bz0, o.p[mt] * Z[mt]);
    ot = mm32(o.ra[1], bz1, ot);
#pragma unroll
    for (int mt = 0; mt < 4; ++mt) zn[mt] = mm32(o.ga[mt][1], bz1, zn[mt]);
    ot = mm16(o.ma, o.vb, ot);
#pragma unroll
    for (int mt = 0; mt < 4; ++mt) Z[mt] = mm16(o.ha[mt], o.vb, zn[mt]);
#pragma unroll
    for (int j = 0; j < 4; ++j) orow[(size_t)(4 * fq + j) * RW] = ot[j];
    asm volatile("" :: "v"(o.ga[0][0]), "v"(o.ga[0][1]), "v"(o.ga[1][0]), "v"(o.ga[1][1]), "v"(o.ga[2][0]), "v"(o.ga[2][1]), "v"(o.ga[3][0]), "v"(o.ga[3][1]),
                 "v"(o.ra[0]), "v"(o.ra[1]), "v"(o.ha[0]), "v"(o.ha[1]), "v"(o.ha[2]), "v"(o.ha[3]), "v"(o.ma), "v"(o.vb), "v"(bz0), "v"(bz1));
}
constexpr int RING_SLOTS = 7, SLOT_B = 16384, AHEAD = 6;
__device__ __forceinline__ void lds_ops(Ops& o, LAS const char* c, int vt, int lane) {
    const int fq = lane >> 4;
#pragma unroll
    for (int mt = 0; mt < 4; ++mt) {
#pragma unroll
        for (int s2 = 0; s2 < 2; ++s2) o.ga[mt][s2] = *(LAS const bf16x8*)(c + O_GA + (mt * 2 + s2) * 1024 + lane * 16);
        o.ha[mt] = *(LAS const s16x4*)(c + O_HA + mt * 512 + lane * 8);
        o.p[mt] = *(LAS const f32x4*)(c + O_P + (16 * mt + 4 * fq) * 4);
    }
    o.ra[0] = *(LAS const bf16x8*)(c + O_RA + lane * 16); o.ra[1] = *(LAS const bf16x8*)(c + O_RA + 1024 + lane * 16);
    o.ma = *(LAS const s16x4*)(c + O_MA + lane * 8); o.vb = *(LAS const s16x4*)(c + O_VB + vt * 512 + lane * 8);
}
__device__ __forceinline__ void seq_wg(const char* c0, int nch, const float* S0, float* o_out, float* s_out, LAS char* lds, int wave, int lane) {
    const int fr = lane & 15, fq = lane >> 4;
#define RAWBAR() do { asm volatile("" ::: "memory"); __builtin_amdgcn_s_barrier(); asm volatile("" ::: "memory"); } while (0)
    if (wave >= 4) {
        const int pw = (wave - 4) * 4;
        const char* src0 = c0 + (size_t)pw * 1024 + lane * 16;
#define FEED(ci, slot) do { const int ci_ = (ci) < nch ? (ci) : nch - 1; const char* s_ = src0 + (size_t)ci_ * CHKB; LAS char* d_ = lds + (slot) * SLOT_B + pw * 1024; \
            _Pragma("unroll") for (int q = 0; q < 4; ++q) __builtin_amdgcn_global_load_lds((const unsigned*)(s_ + q * 1024), (LAS unsigned*)(d_ + q * 1024), 16, 0, 0); } while (0)
#pragma unroll
        for (int i = 0; i < AHEAD; ++i) FEED(i, i);
        asm volatile("s_waitcnt vmcnt(20)" ::: "memory");
        RAWBAR();
        int slot = AHEAD;
        for (int c = 0; c < nch; ++c) {
            FEED(c + AHEAD, slot); slot = (slot == RING_SLOTS - 1) ? 0 : slot + 1;
            asm volatile("s_waitcnt vmcnt(20)" ::: "memory");
            RAWBAR();
        }
        asm volatile("s_waitcnt vmcnt(0)" ::: "memory");
        RAWBAR();
#undef FEED
    } else {
        const int vt = wave;
        f32x4 Z[4];
#pragma unroll
        for (int mt = 0; mt < 4; ++mt) Z[mt] = S0 ? *(const f32x4*)(S0 + (16 * vt + fr) * 64 + 16 * mt + 4 * fq) : (f32x4){0.f, 0.f, 0.f, 0.f};
        float* ocol = o_out + 16 * vt + fr;
        Ops A, B;
        RAWBAR();
        lds_ops(A, lds, vt, lane);
        int slot = 1;
#pragma unroll 1
        for (int c = 0; c < nch; c += 2) {
            asm volatile("s_waitcnt lgkmcnt(0)" ::: "memory");
            RAWBAR();
            lds_ops(B, lds + slot * SLOT_B, vt, lane); slot = (slot == RING_SLOTS - 1) ? 0 : slot + 1;
            step(Z, A, ocol + (size_t)(16 * c) * RW, fq);
            asm volatile("s_waitcnt lgkmcnt(0)" ::: "memory");
            RAWBAR();
            lds_ops(A, lds + slot * SLOT_B, vt, lane); slot = (slot == RING_SLOTS - 1) ? 0 : slot + 1;
            step(Z, B, ocol + (size_t)(16 * (c + 1)) * RW, fq);
        }
#pragma unroll
        for (int mt = 0; mt < 4; ++mt) *(f32x4*)(s_out + (16 * vt + fr) * 64 + 16 * mt + 4 * fq) = Z[mt];
        asm volatile("s_waitcnt lgkmcnt(0)" : "+v"(A.ga[0][0]), "+v"(A.ra[0]) :: "memory");
        RAWBAR();
    }
#undef RAWBAR
}
#undef CHK_LW
}

constexpr int RING_BYTES = 131072;
constexpr int LDSCTL_OFF = RING_BYTES, MISC_OFF = LDSCTL_OFF + 320, XL_OFF = LDSCTL_OFF + 1024;
constexpr int LDS_BYTES = 147456;
static_assert(att::LDS_BYTES <= RING_BYTES && pg8::STAGE_BYTES <= RING_BYTES && XL_OFF + 8192 <= LDS_BYTES, "LDS map");
constexpr int NWAVES = 8, NPHASE = 16;

struct Args { const float* in[35]; float* out; unsigned char* ws; int ph_lo, ph_hi, li, pad; };

__device__ __forceinline__ void transpose_item(const float* W, int K, int N, bf16_t* WT, int row_off, LAS float* scr, int item, int lane) {
    const int nblk = N / 32, kb = item / nblk, nb = item % nblk, k0 = 64 * kb, n0 = 32 * nb;
    float tv[32];
    const float* wsrc = W + (size_t)(k0 + (lane >> 5)) * N + n0 + (lane & 31);
#pragma unroll
    for (int i = 0; i < 32; ++i) tv[i] = wsrc[(size_t)(2 * i) * N];
#pragma unroll
    for (int i = 0; i < 32; ++i) scr[(2 * i + (lane >> 5)) * 33 + (lane & 31)] = tv[i];
    asm volatile("s_waitcnt lgkmcnt(0)" ::: "memory");
    const int c = lane & 7;
#pragma unroll
    for (int j = 0; j < 4; ++j) { const int n = (lane >> 3) + 8 * j; const LAS float* s = scr + (8 * c) * 33 + n;
        u32x4 o; o.x = cvtpk(s[0 * 33], s[1 * 33]); o.y = cvtpk(s[2 * 33], s[3 * 33]); o.z = cvtpk(s[4 * 33], s[5 * 33]); o.w = cvtpk(s[6 * 33], s[7 * 33]);
        *(u32x4*)(WT + (size_t)(row_off + n0 + n) * K + k0 + 8 * c) = o; }
    asm volatile("s_waitcnt lgkmcnt(0)" ::: "memory");
}
__device__ __forceinline__ void convert_weights(const Args& a, int l, LAS unsigned char* lds, int gw, int ngw, int wave, int lane, int which, unsigned* ticket) {
    unsigned char* ws = a.ws;
    bf16_t* wtin = (bf16_t*)(ws + WS_WTIN); bf16_t* wtout = (bf16_t*)(ws + WS_WTOUT); bf16_t* wtuq = (bf16_t*)(ws + WS_WTUQ); bf16_t* wtukv = (bf16_t*)(ws + WS_WTUKV);
    const float* w_in = a.in[12] + (size_t)l * DM * IN_COLS; const float* w_out = a.in[34] + (size_t)l * DM * DM;
    const float* w_uq = a.in[25] + (size_t)l * QL * QW; const float* w_uk = a.in[26] + (size_t)l * KVL * MLAD; const float* w_uv = a.in[27] + (size_t)l * KVL * MLAD;
    LAS float* scr = (LAS float*)(lds + wave * 16384);
    constexpr int I_IN = (DM / 64) * (IN_COLS / 32), I_OUT = (DM / 64) * (DM / 32), I_UQ = (QL / 64) * (QW / 32), I_UK = (KVL / 64) * (MLAD / 32);
    const int n_in = (which & 1) ? I_IN : 0, n_out = (which & 2) ? I_OUT : 0, n_uq = (which & 4) ? I_UQ : 0, n_uk = (which & 4) ? I_UK : 0;
    const int NITEMS = n_in + n_out + n_uq + 2 * n_uk;
    if (!ticket) {
#define CW_DECODE(it_, W_, K_, N_, WT_, off_, r_) do { int r0_ = (it_); W_ = w_in; K_ = DM; N_ = IN_COLS; WT_ = wtin; off_ = 0; \
            if (r0_ >= n_in) { r0_ -= n_in; W_ = w_out; K_ = DM; N_ = DM; WT_ = wtout; \
                if (r0_ >= n_out) { r0_ -= n_out; W_ = w_uq; K_ = QL; N_ = QW; WT_ = wtuq; \
                    if (r0_ >= n_uq) { r0_ -= n_uq; W_ = w_uk; K_ = KVL; N_ = MLAD; WT_ = wtukv; \
                        if (r0_ >= n_uk) { r0_ -= n_uk; W_ = w_uv; off_ = MLAD; } } } } r_ = r0_; } while (0)
#define CW_LOAD(tv_, W_, N_, r_) do { const int nblk_ = (N_) / 32, k0_ = 64 * ((r_) / nblk_), n0_ = 32 * ((r_) % nblk_); \
            const float* wsrc_ = (W_) + (size_t)(k0_ + (lane >> 5)) * (N_) + n0_ + (lane & 31); \
            _Pragma("unroll") for (int i = 0; i < 32; ++i) tv_[i] = wsrc_[(size_t)(2 * i) * (N_)]; } while (0)
        if (gw < NITEMS) {
            const float* Wc; bf16_t* WTc; int Kc, Nc, offc, rc;
            float tv[32];
            CW_DECODE(gw, Wc, Kc, Nc, WTc, offc, rc); CW_LOAD(tv, Wc, Nc, rc);
#pragma unroll 1
            for (int it = gw; it < NITEMS; it += ngw) {
                const int itn = it + ngw < NITEMS ? it + ngw : NITEMS - 1;
                const float* Wn; bf16_t* WTn; int Kn_, Nn, offn, rn;
                float tn[32];
                CW_DECODE(itn, Wn, Kn_, Nn, WTn, offn, rn); CW_LOAD(tn, Wn, Nn, rn);
                {
                    const int nblk = Nc / 32, k0 = 64 * (rc / nblk), n0 = 32 * (rc % nblk);
#pragma unroll
                    for (int i = 0; i < 32; ++i) scr[(2 * i + (lane >> 5)) * 33 + (lane & 31)] = tv[i];
                    asm volatile("s_waitcnt lgkmcnt(0)" ::: "memory");
                    const int c = lane & 7;
#pragma unroll
                    for (int j = 0; j < 4; ++j) { const int n = (lane >> 3) + 8 * j; const LAS float* sp = scr + (8 * c) * 33 + n;
                        u32x4 o; o.x = cvtpk(sp[0 * 33], sp[1 * 33]); o.y = cvtpk(sp[2 * 33], sp[3 * 33]); o.z = cvtpk(sp[4 * 33], sp[5 * 33]); o.w = cvtpk(sp[6 * 33], sp[7 * 33]);
                        *(u32x4*)(WTc + (size_t)(offc + n0 + n) * Kc + k0 + 8 * c) = o; }
                    asm volatile("s_waitcnt lgkmcnt(0)" ::: "memory");
                }
#pragma unroll
                for (int i = 0; i < 32; ++i) tv[i] = tn[i];
                Wc = Wn; WTc = WTn; Kc = Kn_; Nc = Nn; offc = offn; rc = rn;
            }
        }
#undef CW_DECODE
#undef CW_LOAD
    } else {
    int it = gw, left = 0;
    for (;; ) {
        if (ticket) {
            if (left == 0) { unsigned tk = 0; if (lane == 0) tk = __hip_atomic_fetch_add(ticket, 8u, __ATOMIC_RELAXED, __HIP_MEMORY_SCOPE_AGENT); it = (int)__builtin_amdgcn_readfirstlane(tk); left = 8; }
            else ++it;
            --left;
        }
        if (it >= NITEMS) break;
        int r = it;
        if (!ticket) it += ngw;
        if (r < n_in) { transpose_item(w_in, DM, IN_COLS, wtin, 0, scr, r, lane); continue; } r -= n_in;
        if (r < n_out) { transpose_item(w_out, DM, DM, wtout, 0, scr, r, lane); continue; } r -= n_out;
        if (r < n_uq) { transpose_item(w_uq, QL, QW, wtuq, 0, scr, r, lane); continue; } r -= n_uq;
        if (r < n_uk) { transpose_item(w_uk, KVL, MLAD, wtukv, 0, scr, r, lane); continue; } r -= n_uk;
        transpose_item(w_uv, KVL, MLAD, wtukv, MLAD, scr, r, lane);
    }
    }
    if (which & 1) { unsigned zz; asm volatile("v_mov_b32 %0, 0" : "=v"(zz));
        for (int p = gw * 64 + lane; p < 64 * DM / 8; p += ngw * 64) *(u32x4*)(wtin + (size_t)IN_COLS * DM + (size_t)p * 8) = (u32x4){zz, zz, zz, zz}; }
}

#define PHASE_LOCALS \
    int t__ = threadIdx.x; asm volatile("" : "+v"(t__)); \
    unsigned long long z__ = 0; asm volatile("" : "+s"(z__)); \
    unsigned char* ws = args.ws + z__; float* out = args.out + z__; \
    int g__ = (int)gridDim.x, b__ = (int)blockIdx.x; asm volatile("" : "+s"(g__), "+s"(b__)); const int G = g__, bx = b__;     \
    const int tid = t__, lane = tid & 63, wave = __builtin_amdgcn_readfirstlane(tid >> 6); \
    const int gw = bx * NWAVES + wave, ngw = G * NWAVES; \
    float2* tab = (float2*)(ws + WS_TAB); float* modp = (float*)(ws + WS_MODP); float* modf = (float*)(ws + WS_MODF); float* rkdot = (float*)(ws + WS_RKDOT); \
    bf16_t* wtin = (bf16_t*)(ws + WS_WTIN); bf16_t* wtout = (bf16_t*)(ws + WS_WTOUT); bf16_t* wtuq = (bf16_t*)(ws + WS_WTUQ); bf16_t* wtukv = (bf16_t*)(ws + WS_WTUKV); \
    bf16_t* hmix = (bf16_t*)(ws + WS_HMIX); bf16_t* proj = (bf16_t*)(ws + WS_PROJ); bf16_t* Kn = (bf16_t*)(ws + WS_KN); bf16_t* Vb = (bf16_t*)(ws + WS_V); \
    char* scanrec = (char*)(ws + WS_SCAN); bf16_t* Qb = (bf16_t*)(ws + WS_Q); bf16_t* latall = (bf16_t*)(ws + WS_LAT); bf16_t* Krb = (bf16_t*)(ws + WS_KR); \
    float* obuf = (float*)(ws + WS_OBUF); bf16_t* qin = (bf16_t*)(ws + WS_QIN); \
    const float* xp = l == 0 ? args.in[0] : out + O_YP; const float* xs = l == 0 ? args.in[1] : out + O_YS; \
    const float* modf_l = modf + (size_t)l * 20 * 3 * DM; \
    (void)tid; (void)lane; (void)wave; (void)gw; (void)ngw; (void)tab; (void)modp; (void)modf; (void)rkdot; (void)wtin; (void)wtout; (void)wtuq; (void)wtukv; (void)hmix; (void)proj; (void)Kn; (void)Vb; \
    (void)scanrec; (void)Qb; (void)latall; (void)Krb; (void)obuf; (void)qin; (void)xp; (void)xs; (void)modf_l;
__global__ void __launch_bounds__(NWAVES * 64, 2) mk_fwd(Args args) {
    extern __shared__ __attribute__((aligned(16))) unsigned char lds_raw[];
    LAS unsigned char* lds = (LAS unsigned char*)lds_raw;
    volatile LAS unsigned* MISC = (volatile LAS unsigned*)(lds + MISC_OFF);
    const int G = gridDim.x, bx = blockIdx.x;
    unsigned* ctl = (unsigned*)(args.ws + WS_CTL);
    for (int u = threadIdx.x; u < (LDS_BYTES - LDSCTL_OFF) / 4; u += NWAVES * 64) ((LAS unsigned*)(lds + LDSCTL_OFF))[u] = 0u;
    __syncthreads();
    XcdBarrier bar = xcd_barrier_post(ctl + CW_BAR + args.li * XCD_BAR_WORDS, MISC + 8);
    const int lo = args.ph_lo, hi = args.ph_hi;
#define IN(k) (lo <= (k) && (k) < hi)
#define SEAM(k) do { if (IN(k) && IN((k) + 1)) xcd_barrier(bar); } while (0)

    if (IN(0) && EN(0)) {
        const int l = 0; PHASE_LOCALS
        for (int i = bx * 512 + tid; i < 4096 * 32; i += G * 512) {
            const int pos = i >> 5, fi = i & 31;
            const float ang = (float)pos * ROPE_FREQ[fi];
            double rev = (double)ang * 0.15915494309189535; rev -= __builtin_rint(rev);
            const float fr = (float)rev;
            tab[i] = make_float2(__builtin_amdgcn_cosf(fr), __builtin_amdgcn_sinf(fr));
        }
        {
            LAS float* cs = (LAS float*)lds;
            for (int w0 = bx; w0 < 256; w0 += G) {
                const int p = w0 % 24, sl = w0 / 24, np = p < 16 ? 11 : 10;
                const int lm = p / 12, cg = p % 12, col = cg * 1024 + tid * 2;
                f32x2 acc[20];
#pragma unroll
                for (int r2 = 0; r2 < 20; ++r2) acc[r2] = (f32x2){0.f, 0.f};
                for (int ch = sl; ch < 32; ch += np) {
                    const int k0 = ch * 128;
                    __syncthreads();
                    for (int e = tid; e < 20 * 128; e += 512) { const int row = e >> 7, k = e & 127;
                        cs[e] = row < 4 ? args.in[2][(size_t)row * DM + k0 + k] : args.in[3][(size_t)(row - 4) * DM + k0 + k]; }
                    __syncthreads();
                    const float* wp = args.in[9] + ((size_t)lm * DM + k0) * (3 * DM) + col;
#pragma unroll 2
                    for (int k = 0; k < 128; k += 4) {
                        const f32x2 wa = *(const f32x2*)(wp + (size_t)(k + 0) * (3 * DM)), wb = *(const f32x2*)(wp + (size_t)(k + 1) * (3 * DM));
                        const f32x2 wc = *(const f32x2*)(wp + (size_t)(k + 2) * (3 * DM)), wd = *(const f32x2*)(wp + (size_t)(k + 3) * (3 * DM));
#pragma unroll
                        for (int r2 = 0; r2 < 20; ++r2) { const f32x4 cv = *(LAS const f32x4*)(cs + r2 * 128 + k);
                            acc[r2] = wa * cv.x + acc[r2]; acc[r2] = wb * cv.y + acc[r2]; acc[r2] = wc * cv.z + acc[r2]; acc[r2] = wd * cv.w + acc[r2]; }
                    }
                }
                float* mp = modp + ((size_t)(lm * 11 + sl) * 20) * (3 * DM) + col;
#pragma unroll
                for (int r2 = 0; r2 < 20; ++r2) *(f32x2*)(mp + (size_t)r2 * (3 * DM)) = acc[r2];
            }
            __syncthreads();
        }
        {
            unsigned* w2p = (unsigned*)(ws + WS_W2P);
            for (int i = bx * 512 + tid; i < 2 * 2 * 32 * RW; i += G * 512) {
                const int c = i & 1023, ip = (i >> 10) & 31, mat = (i >> 15) & 1, lw_ = i >> 16;
                const float* src = (mat ? args.in[17] : args.in[15]) + (size_t)lw_ * 64 * RW;
                w2p[i] = cvtpk(src[(size_t)(2 * ip) * RW + c], src[(size_t)(2 * ip + 1) * RW + c]);
            }
        }
        convert_weights(args, 0, lds, gw, ngw, wave, lane, 7, nullptr);
    }
    SEAM(0);
    if (IN(1) && EN(1)) {
        const int l = 0; PHASE_LOCALS
        for (int i = bx * 512 + tid; i < 2 * 20 * DM; i += G * 512) {
            const int lf = i / (20 * DM), r = i % (20 * DM), seq = r / DM, col = r % DM;
            float sh = args.in[10][(size_t)lf * 3 * DM + col], sc = args.in[10][(size_t)lf * 3 * DM + DM + col], gt = args.in[10][(size_t)lf * 3 * DM + 2 * DM + col];
            for (int which = 0; which < 3; ++which) {
                const int c3 = which * DM + col, p = lf * 12 + (c3 >> 10);
                const int np = p < 16 ? 11 : 10;
                float a = 0.f;
                for (int sl = 0; sl < np; ++sl) a += modp[((size_t)(lf * 11 + sl) * 20 + seq) * (3 * DM) + c3];
                if (which == 0) sh += a; else if (which == 1) sc += a; else gt += a; }
            float* mf = modf + ((size_t)(lf * 20 + seq) * 3) * DM;
            mf[col] = args.in[11][(size_t)lf * DM + col] * (1.f + sc); mf[DM + col] = sh; mf[2 * DM + col] = gt;
        }
    }
    SEAM(1);

    for (int l = 0; l < DEPTH; ++l) {
        const int pb = 2 + 7 * l;
        if (IN(pb + 0) && EN(2)) {
            const bool splitA = (G == 256);
#define NORM_ROW(m) do { \
                const float* xr = (m) < MP ? xp + (size_t)(m) * DM : xs + (size_t)((m) - MP) * DM; \
                const int seq = (m) < MP ? ((m) >> 12) : 4 + (((m) - MP) >> 5); \
                const f32x4* x4 = (const f32x4*)xr + lane; \
                f32x4 v[16]; float ss = 0.f; \
                _Pragma("unroll") for (int j = 0; j < 16; ++j) { v[j] = x4[64 * j]; ss += (v[j].x * v[j].x + v[j].y * v[j].y) + (v[j].z * v[j].z + v[j].w * v[j].w); } \
                const float rstd = rsqrtf(wave_sum(ss) * (1.f / DM) + NORM_EPS); \
                const f32x4* A4 = (const f32x4*)(modf_l + (size_t)(seq * 3 + 0) * DM) + lane; \
                const f32x4* B4 = (const f32x4*)(modf_l + (size_t)(seq * 3 + 1) * DM) + lane; \
                u32x2* o8 = (u32x2*)(hmix + (size_t)(m) * DM) + lane; \
                _Pragma("unroll") for (int j = 0; j < 16; ++j) { const f32x4 av = A4[64 * j], bv = B4[64 * j]; const f32x4 y = v[j] * rstd * av + bv; \
                    u32x2 w; w.x = cvtpk(y.x, y.y); w.y = cvtpk(y.z, y.w); o8[64 * j] = w; } } while (0)
            {
                PHASE_LOCALS
                if (splitA) { for (int m = MP + gw; m < M; m += ngw) NORM_ROW(m); }
            }
            if (splitA) xcd_barrier(bar);
            {
                PHASE_LOCALS
                if (splitA && bx < 94) {
                    pg8::Gemm g{hmix + (size_t)MP * DM, wtin, MS, NPAD, DM}; pg8::StaticOrder S; S.init(MS, NPAD, 94, bx);
                    pg8::EpiBf16 E{proj + (size_t)MP * NPAD, NPAD, 0, 0};
                    pg8::gemm_phase<pg8::EpiBf16, pg8::StaticOrder, true, true>(lds, g, S, E);
                } else {
                    const int nw0 = splitA ? (bx - 94) * NWAVES + wave : gw, nnw = splitA ? (G - 94) * NWAVES : ngw;
                    if (l > 0) convert_weights(args, l, lds, nw0, nnw, wave, lane, 2, nullptr);
                    for (int m = nw0; m < (splitA ? MP : M); m += nnw) NORM_ROW(m);
                }
            }
#undef NORM_ROW
        }
        SEAM(pb + 0);
        if (IN(pb + 1) && EN(3)) {
            PHASE_LOCALS
            const int MB = (G == 256) ? MP : M;
            pg8::Gemm g{hmix, wtin, MB, NPAD, DM}; pg8::StaticOrder S; S.init(MB, NPAD, G, bx);
            pg8::EpiBf16 E{proj, NPAD, 0, 0};
            pg8::gemm_phase<pg8::EpiBf16, pg8::StaticOrder, true, true>(lds, g, S, E);
        }
        SEAM(pb + 1);
        if (IN(pb + 2) && EN(4)) {
            PHASE_LOCALS
            {
                LAS unsigned* actP = (LAS unsigned*)lds;
                const unsigned* w2pl = (const unsigned*)(ws + WS_W2P) + (size_t)l * 2 * 32 * RW;
                const float* mu = args.in[13] + (size_t)l * SHIFT_DIM;
                const float* w0p = args.in[14] + (size_t)l * RW; const float* w2p = args.in[15] + (size_t)l * 64 * RW;
                const float* a0p = args.in[16] + (size_t)l * RW; const float* a2p = args.in[17] + (size_t)l * 64 * RW;
                const float* kkp = args.in[18] + (size_t)l * RW; const float* kap = args.in[19] + (size_t)l * RW; const float* rkp = args.in[20] + (size_t)l * RW;
                const int h = tid >> 5, kp = tid & 31, c0 = 2 * tid;
                const f32x2 mu_r = *(const f32x2*)(mu + c0), mu_k = *(const f32x2*)(mu + RW + c0), mu_v = *(const f32x2*)(mu + 2 * RW + c0);
                const f32x2 w0v = *(const f32x2*)(w0p + c0), a0v = *(const f32x2*)(a0p + c0), kkw = *(const f32x2*)(kkp + c0), kaw = *(const f32x2*)(kap + c0), rkw = *(const f32x2*)(rkp + c0);
                for (int tile = bx; tile < M / 16; tile += G) {
                    const int m0 = tile * 16;
                    const bool smp = m0 >= MP;
                    const int b = smp ? ((m0 - MP) >> 5) : (m0 >> 12), t0 = smp ? ((m0 - MP) & 31) : (m0 & 4095);
                    const bool first = t0 == 0;
                    const float* shst = args.in[7] + (size_t)(l * DB + b) * SHIFT_DIM;
                    const size_t rec0 = smp ? (size_t)SREC_S0 + (size_t)(b * 16 + h) * DS + t0 : (size_t)(b * 16 + h) * SEQ + t0;
                    __syncthreads();
#pragma unroll
                    for (int e = 0; e < 4; ++e) { const int idx = tid + 512 * e, tok = idx >> 7, i = idx & 127, col = 3072 + i, m = m0 + tok;
                        const float cur = bf2f(proj[(size_t)m * NPAD + col]);
                        float prev;
                        if (tok == 0 && first) prev = smp ? shst[col] : 0.f; else prev = bf2f(proj[(size_t)(m - 1) * NPAD + col]);
                        float xsv = cur + (prev - cur) * mu[col];
                        if (i < 64) { const float e2 = __expf(2.f * xsv); xsv = 1.f - 2.f * __builtin_amdgcn_rcpf(e2 + 1.f); }
                        const float xo = __shfl_xor(xsv, 1);
                        if (!(i & 1)) actP[(i >> 1) * 16 + tok] = cvtpk(xsv, xo); }
                    __syncthreads();
                    unsigned pur[17], puk[17], puv[17];
#pragma unroll
                    for (int tok = 0; tok < 17; ++tok) { if (tok == 0 && first) { pur[0] = puk[0] = puv[0] = 0u; continue; }
                        const bf16_t* pp = proj + (size_t)(m0 + tok - 1) * NPAD + c0; pur[tok] = *(const unsigned*)pp; puk[tok] = *(const unsigned*)(pp + RW); puv[tok] = *(const unsigned*)(pp + 2 * RW); }
                    float lw[16][2], la[16][2];
#pragma unroll
                    for (int t = 0; t < 16; ++t) { lw[t][0] = 0.f; lw[t][1] = 0.f; la[t][0] = 0.f; la[t][1] = 0.f; }
                    u32x2 wvn = *(const u32x2*)(w2pl + c0), avn = *(const u32x2*)(w2pl + (size_t)32 * RW + c0);
                    for (int ip = 0; ip < 32; ++ip) {
                        const u32x2 wv = wvn, av = avn;
                        { const int ipn = ip < 31 ? ip + 1 : 31; wvn = *(const u32x2*)(w2pl + (size_t)ipn * RW + c0); avn = *(const u32x2*)(w2pl + (size_t)(32 + ipn) * RW + c0); }
#pragma unroll
                        for (int tq = 0; tq < 4; ++tq) { const u32x4 x4 = *(LAS const u32x4*)(actP + ip * 16 + tq * 4), y4 = *(LAS const u32x4*)(actP + (32 + ip) * 16 + tq * 4);
#pragma unroll
                            for (int e = 0; e < 4; ++e) { lw[tq * 4 + e][0] = DOT2(x4[e], wv.x, lw[tq * 4 + e][0]); lw[tq * 4 + e][1] = DOT2(x4[e], wv.y, lw[tq * 4 + e][1]);
                                                          la[tq * 4 + e][0] = DOT2(y4[e], av.x, la[tq * 4 + e][0]); la[tq * 4 + e][1] = DOT2(y4[e], av.y, la[tq * 4 + e][1]); } }
                    }
                    float pr[2], pk[2], pv[2];
                    if (first) { if (smp) { pr[0] = shst[c0]; pr[1] = shst[c0 + 1]; pk[0] = shst[RW + c0]; pk[1] = shst[RW + c0 + 1]; pv[0] = shst[2 * RW + c0]; pv[1] = shst[2 * RW + c0 + 1]; }
                                 else { pr[0] = pr[1] = pk[0] = pk[1] = pv[0] = pv[1] = 0.f; } }
                    else { const unsigned ur = pur[0], uk = puk[0], uv = puv[0];
                           pr[0] = bflo(ur); pr[1] = bfhi(ur); pk[0] = bflo(uk); pk[1] = bfhi(uk); pv[0] = bflo(uv); pv[1] = bfhi(uv); }
#pragma unroll
                    for (int tok = 0; tok < 16; ++tok) {
                        const int m = m0 + tok;
                        const unsigned ur = pur[tok + 1], uk = puk[tok + 1], uv = puv[tok + 1];
                        const float cr[2] = {bflo(ur), bfhi(ur)}, ck[2] = {bflo(uk), bfhi(uk)}, cv[2] = {bflo(uv), bfhi(uv)};
                        float rr[2], kk[2], vv[2], dec[2], aa[2], kkn[2], km[2], bb[2];
                        rr[0] = cr[0] + (pr[0] - cr[0]) * mu_r.x; rr[1] = cr[1] + (pr[1] - cr[1]) * mu_r.y;
                        kk[0] = ck[0] + (pk[0] - ck[0]) * mu_k.x; kk[1] = ck[1] + (pk[1] - ck[1]) * mu_k.y;
                        vv[0] = cv[0] + (pv[0] - cv[0]) * mu_v.x; vv[1] = cv[1] + (pv[1] - cv[1]) * mu_v.y;
                        dec[0] = __expf(-0.6065306597126334f * sigmoidf_(w0v.x + lw[tok][0])); dec[1] = __expf(-0.6065306597126334f * sigmoidf_(w0v.y + lw[tok][1]));
                        aa[0] = sigmoidf_(a0v.x + la[tok][0]); aa[1] = sigmoidf_(a0v.y + la[tok][1]);
                        kkn[0] = kk[0] * kkw.x; kkn[1] = kk[1] * kkw.y;
                        const float ssq = sum32(kkn[0] * kkn[0] + kkn[1] * kkn[1]);
                        const float inv = rsqrtf(ssq + 1e-12f);
                        kkn[0] *= inv; kkn[1] *= inv;
                        km[0] = kk[0] * (1.f + (aa[0] - 1.f) * kaw.x); km[1] = kk[1] * (1.f + (aa[1] - 1.f) * kaw.y);
                        bb[0] = kkn[0] * aa[0]; bb[1] = kkn[1] * aa[1];
                        const float rkd = sum32(rr[0] * km[0] * rkw.x + rr[1] * km[1] * rkw.y);
                        if (kp == 0) rkdot[(size_t)m * 16 + h] = rkd;
                        char* rec = scanrec + (rec0 + tok) * REC;
                        *(f32x2*)(rec + kp * 8) = (f32x2){dec[0], dec[1]};
                        *(f32x2*)(rec + 256 + kp * 8) = (f32x2){kkn[0], kkn[1]};
                        *(f32x2*)(rec + 512 + kp * 8) = (f32x2){bb[0], bb[1]};
                        *(unsigned*)(rec + 768 + kp * 4) = cvtpk(rr[0], rr[1]);
                        *(unsigned*)(rec + 896 + kp * 4) = cvtpk(km[0], km[1]);
                        *(unsigned*)(rec + 1024 + kp * 4) = cvtpk(vv[0], vv[1]);
                        pr[0] = cr[0]; pr[1] = cr[1]; pk[0] = ck[0]; pk[1] = ck[1]; pv[0] = cv[0]; pv[1] = cv[1];
                    }
                }
                __syncthreads();
            }
            {
                const float* gq = args.in[23] + (size_t)l * QL; const float* gkv = args.in[24] + (size_t)l * KVL; const float* gkr = args.in[31] + (size_t)l * ROPE;
                const float* cw = args.in[32] + (size_t)l * 3 * CONVD; const float* cb = args.in[33] + (size_t)l * CONVD;
                for (int m = gw; m < M; m += ngw) {
                    const bool smp = m >= MP;
                    const int b = smp ? ((m - MP) >> 5) : (m >> 12), t = smp ? ((m - MP) & 31) : (m & 4095);
                    const int pos = smp ? PAST + t : t;
                    const int T = smp ? DS : SEQ;
                    const size_t lrow = smp ? (size_t)MP + (size_t)b * SKEYS + PAST + t : (size_t)m;
                    float* lat_out = smp ? out + O_LATS + ((size_t)(l * DB + b) * DS + t) * KVL : out + O_LATP + ((size_t)(l * NB + b) * SEQ + t) * KVL;
                    float* kr_out = smp ? out + O_KRS + ((size_t)(l * DB + b) * DS + t) * ROPE : out + O_KRP + ((size_t)(l * NB + b) * SEQ + t) * ROPE;
                    const bf16_t* prow = proj + (size_t)m * NPAD;
                    const u32x4 rq0 = *(const u32x4*)(prow + C_CQ + lane * 8), rq1 = *(const u32x4*)(prow + C_CQ + 512 + lane * 8), rkv = *(const u32x4*)(prow + C_CKV + lane * 8);
                    const bf16_t rkr = prow[C_KR + lane];
                    u32x4 rgt[6];
#pragma unroll
                    for (int j = 0; j < 6; ++j) { const int c = j * 512 + lane * 8; rgt[j] = *(const u32x4*)(prow + (c < RW ? C_RWGATE + c : C_MGATE + (c - RW))); }
                    const bf16_t* prow1 = t >= 1 ? prow - NPAD : prow; const bf16_t* prow2 = t >= 2 ? prow - 2 * NPAD : prow;
                    u32x4 rcc[2][3], rcx[2][3], rvb[2], rvg[2];
#pragma unroll
                    for (int j = 0; j < 2; ++j) { const int c = j * 512 + lane * 8;
                        rcc[j][0] = *(const u32x4*)(prow + C_CVC + c); rcx[j][0] = *(const u32x4*)(prow + C_CVX + c);
                        rcc[j][1] = *(const u32x4*)(prow1 + C_CVC + c); rcx[j][1] = *(const u32x4*)(prow1 + C_CVX + c);
                        rcc[j][2] = *(const u32x4*)(prow2 + C_CVC + c); rcx[j][2] = *(const u32x4*)(prow2 + C_CVX + c);
                        rvb[j] = *(const u32x4*)(prow + C_CVB + c); rvg[j] = *(const u32x4*)(prow + C_CVG + c); }
                    const float2 cs = tab[pos * 32 + (lane & 31)];
                    {
                        float f[16]; unpack8(rq0, f); unpack8(rq1, f + 8);
                        float ss = 0.f;
#pragma unroll
                        for (int e = 0; e < 16; ++e) ss += f[e] * f[e];
                        const float rstd = rsqrtf(wave_sum(ss) * (1.f / QL) + NORM_EPS);
#pragma unroll
                        for (int j = 0; j < 2; ++j) { const f32x4 g0 = *(const f32x4*)(gq + j * 512 + lane * 8), g1 = *(const f32x4*)(gq + j * 512 + lane * 8 + 4);
                            float y[8];
#pragma unroll
                            for (int e = 0; e < 4; ++e) { y[e] = f[j * 8 + e] * rstd * g0[e]; y[4 + e] = f[j * 8 + 4 + e] * rstd * g1[e]; }
                            *(u32x4*)(qin + (size_t)m * QL + j * 512 + lane * 8) = pack8(y); }
                    }
                    {
                        float f[8]; unpack8(rkv, f);
                        float ss = 0.f;
#pragma unroll
                        for (int e = 0; e < 8; ++e) ss += f[e] * f[e];
                        const float rstd = rsqrtf(wave_sum(ss) * (1.f / KVL) + NORM_EPS);
                        const f32x4 g0 = *(const f32x4*)(gkv + lane * 8), g1 = *(const f32x4*)(gkv + lane * 8 + 4);
                        float y[8];
#pragma unroll
                        for (int e = 0; e < 4; ++e) { y[e] = f[e] * rstd * g0[e]; y[4 + e] = f[4 + e] * rstd * g1[e]; }
                        *(f32x4*)(lat_out + lane * 8) = (f32x4){y[0], y[1], y[2], y[3]}; *(f32x4*)(lat_out + lane * 8 + 4) = (f32x4){y[4], y[5], y[6], y[7]};
                        *(u32x4*)(latall + lrow * KVL + lane * 8) = pack8(y);
                    }
                    {
                        const float x = bf2f(rkr);
                        const float rstd = rsqrtf(wave_sum(x * x) * (1.f / ROPE) + NORM_EPS);
                        const float y = x * rstd * gkr[lane];
                        const float pt = __shfl_xor(y, 32);
                        const float o = lane < 32 ? y * cs.x - pt * cs.y : y * cs.x + pt * cs.y;
                        kr_out[lane] = o; Krb[lrow * ROPE + lane] = f2bf(o);
                    }
                    {
                        const float* cbuf = args.in[8] + (size_t)(l * DB + b) * 2 * CONVD;
                        float* cv_out = smp ? out + O_CVS + (size_t)(l * DB + b) * 2 * CONVD : out + O_CVP + (size_t)(l * NB + b) * 2 * CONVD;
#pragma unroll
                        for (int j = 0; j < 2; ++j) {
                            const int c = j * 512 + lane * 8;
                            float u0[8], u1[8], u2[8], fa[8], fb[8];
                            unpack8(rcc[j][0], fa); unpack8(rcx[j][0], fb);
#pragma unroll
                            for (int e = 0; e < 8; ++e) u0[e] = fa[e] * fb[e];
                            if (t >= 1) { unpack8(rcc[j][1], fa); unpack8(rcx[j][1], fb);
#pragma unroll
                                for (int e = 0; e < 8; ++e) u1[e] = fa[e] * fb[e]; }
                            else {
#pragma unroll
                                for (int e = 0; e < 8; ++e) u1[e] = smp ? cbuf[CONVD + c + e] : 0.f; }
                            if (t >= 2) { unpack8(rcc[j][2], fa); unpack8(rcx[j][2], fb);
#pragma unroll
                                for (int e = 0; e < 8; ++e) u2[e] = fa[e] * fb[e]; }
                            else {
#pragma unroll
                                for (int e = 0; e < 8; ++e) u2[e] = smp ? cbuf[t * CONVD + c + e] : 0.f; }
                            float vb[8], vg[8], y[8];
                            unpack8(rvb[j], vb); unpack8(rvg[j], vg);
#pragma unroll
                            for (int e = 0; e < 8; ++e) { const float yy = cb[c + e] + u2[e] * cw[c + e] + u1[e] * cw[CONVD + c + e] + u0[e] * cw[2 * CONVD + c + e];
                                y[e] = vb[e] * yy * siluf_(vg[e]); }
                            *(u32x4*)(hmix + (size_t)m * DM + 3072 + c) = pack8(y);
                            if (t >= T - 2) { float* co = cv_out + (size_t)(t - (T - 2)) * CONVD + c;
                                *(f32x4*)co = (f32x4){u0[0], u0[1], u0[2], u0[3]}; *(f32x4*)(co + 4) = (f32x4){u0[4], u0[5], u0[6], u0[7]}; }
                        }
                    }
#pragma unroll
                    for (int j = 0; j < 6; ++j) {
                        const int c = j * 512 + lane * 8;
                        float f[8]; unpack8(rgt[j], f);
#pragma unroll
                        for (int e = 0; e < 8; ++e) f[e] = siluf_(f[e]);
                        *(u32x4*)(hmix + (size_t)m * DM + c) = pack8(f);
                    }
                }
            }
            {
                const float* clat = args.in[4] + (size_t)l * DB * PAST * KVL; const float* ckr = args.in[5] + (size_t)l * DB * PAST * ROPE;
                if (G == 256) {
                    for (int r0 = gw; r0 < DB * PAST; r0 += 4 * 2048) {
                        f32x4 a0[4], a1[4]; float kx[4];
#pragma unroll
                        for (int q = 0; q < 4; ++q) { const int r = r0 + q * 2048;
                            a0[q] = *(const f32x4*)(clat + (size_t)r * KVL + lane * 8); a1[q] = *(const f32x4*)(clat + (size_t)r * KVL + lane * 8 + 4); kx[q] = ckr[(size_t)r * ROPE + lane]; }
#pragma unroll
                        for (int q = 0; q < 4; ++q) { const int r = r0 + q * 2048;
                            const int b = r >> 11, p = r & 2047; const size_t lrow = (size_t)MP + (size_t)b * SKEYS + p;
                            u32x4 w; w.x = cvtpk(a0[q].x, a0[q].y); w.y = cvtpk(a0[q].z, a0[q].w); w.z = cvtpk(a1[q].x, a1[q].y); w.w = cvtpk(a1[q].z, a1[q].w);
                            *(u32x4*)(latall + lrow * KVL + lane * 8) = w;
                            Krb[lrow * ROPE + lane] = f2bf(kx[q]); }
                    }
                } else {
                    for (int r = gw; r < DB * PAST; r += ngw) {
                        const int b = r >> 11, p = r & 2047; const size_t lrow = (size_t)MP + (size_t)b * SKEYS + p;
                        const f32x4 a0 = *(const f32x4*)(clat + (size_t)r * KVL + lane * 8), a1 = *(const f32x4*)(clat + (size_t)r * KVL + lane * 8 + 4);
                        u32x4 w; w.x = cvtpk(a0.x, a0.y); w.y = cvtpk(a0.z, a0.w); w.z = cvtpk(a1.x, a1.y); w.w = cvtpk(a1.z, a1.w);
                        *(u32x4*)(latall + lrow * KVL + lane * 8) = w;
                        Krb[lrow * ROPE + lane] = f2bf(ckr[(size_t)r * ROPE + lane]);
                    }
                }
            }
            for (int i = bx * 512 + tid; i < 20 * SHIFT_DIM; i += G * 512) {
                const int seq = i / SHIFT_DIM, col = i % SHIFT_DIM;
                const int mlast = seq < 4 ? seq * SEQ + SEQ - 1 : MP + (seq - 4) * DS + DS - 1;
                float* dst = seq < 4 ? out + O_SHP + (size_t)(l * NB + seq) * SHIFT_DIM : out + O_SHS + (size_t)(l * DB + (seq - 4)) * SHIFT_DIM;
                dst[col] = bf2f(proj[(size_t)mlast * NPAD + col]);
            }
        }
        SEAM(pb + 2);
        if (IN(pb + 3) && EN(5)) {
            {
                PHASE_LOCALS
                char* chkb = (char*)(ws + WS_CHK);
                LAS char* wl = (LAS char*)lds + wave * 16384;
                constexpr int NIT = NB * 16 * (SEQ / 16) + DB * 16 * (DS / 16), NPR = NB * 16 * (SEQ / 16);
#define REC_OF(it_) ((it_) < NPR ? scanrec + (size_t)(it_) * 16 * REC   : scanrec + ((size_t)SREC_S0 + (size_t)((it_) - NPR) * 16) * REC)
#pragma unroll 1
                for (int it = gw; it < NIT; it += ngw) chk::precompute(REC_OF(it), chkb + (size_t)it * chk::CHKB, wl, lane);
#undef REC_OF
            }
            xcd_barrier(bar);
            {
                PHASE_LOCALS
                const char* chkb = (const char*)(ws + WS_CHK);
                const bool split = (G == 256);
                const bool do_gemm = !split || bx >= 64, do_scan = !split || bx < 64;
                const int GG = split ? 192 : G, gc = split ? bx - 64 : bx;
                if (do_gemm) {
                    if (EN(10)) { pg8::Gemm g{qin, wtuq, M, QW, QL}; pg8::StaticOrder S; S.init(M, QW, GG, gc);
                      pg8::EpiBf16 E{Qb, QW, 0, 0};
                      pg8::gemm_phase<pg8::EpiBf16, pg8::StaticOrder, true, true>(lds, g, S, E); }
                }
                if (EN(11)) {
                    pg8::Gemm g{latall, wtukv, KROWS, 2 * MLAD, KVL};
                    pg8::EpiKV E{Kn, Vb, args.in[30] + (size_t)l * 128, (LAS float*)(lds + XL_OFF)};
                    if (split) { pg8::KvOrder S; S.init(KROWS, 2 * MLAD, bx); pg8::gemm_phase<pg8::EpiKV, pg8::KvOrder, true, true>(lds, g, S, E); }
                    else { pg8::StaticOrder S; S.init(KROWS, 2 * MLAD, G, (bx + G / 2) % G); pg8::gemm_phase<pg8::EpiKV, pg8::StaticOrder, true, true>(lds, g, S, E); }
                }
                __syncthreads();
                if (do_scan && EN(9)) {
                    const int sw = split ? bx : bx, nsw = split ? 64 : G;
#pragma unroll 1
                    for (int bh = sw; bh < NB * 16; bh += nsw) {
                        const int b = bh >> 4, h = bh & 15;
                        chk::seq_wg(chkb + (size_t)bh * (SEQ / 16) * chk::CHKB, SEQ / 16, nullptr, obuf + (size_t)b * SEQ * RW + h * 64,
                                    out + O_RWP + ((size_t)(l * NB + b) * 16 + h) * 4096, (LAS char*)lds, wave, lane);
                    }
#pragma unroll 1
                    for (int bh = sw; bh < DB * 16; bh += nsw) {
                        const int b = bh >> 4, h = bh & 15;
                        chk::seq_wg(chkb + ((size_t)NB * 16 * (SEQ / 16) + (size_t)bh * (DS / 16)) * chk::CHKB, DS / 16, args.in[6] + ((size_t)(l * DB + b) * 16 + h) * 4096,
                                    obuf + ((size_t)MP + (size_t)b * DS) * RW + h * 64, out + O_RWS + ((size_t)(l * DB + b) * 16 + h) * 4096, (LAS char*)lds, wave, lane);
                    }
                    __syncthreads();
                }
            }
        }
        SEAM(pb + 3);
        if (IN(pb + 4) && EN(6)) {
            PHASE_LOCALS
            const float* lng = args.in[21] + (size_t)l * RW; const float* lnb = args.in[22] + (size_t)l * RW;
            const int l16 = lane & 15, g16 = lane >> 4;
            for (int m = gw; m < M; m += ngw) {
                const bool smp = m >= MP;
                const int b = smp ? ((m - MP) >> 5) : (m >> 12), t = smp ? ((m - MP) & 31) : (m & 4095);
                f32x4 ov4[4], lg4[4], lb4[4]; u32x2 vu4[4], gg4[4]; float rk4[4];
#pragma unroll
                for (int p = 0; p < 4; ++p) {
                    const int h = p * 4 + g16, c = h * 64 + l16 * 4;
                    const size_t rec = smp ? (size_t)SREC_S0 + (size_t)(b * 16 + h) * DS + t : (size_t)(b * 16 + h) * SEQ + t;
                    ov4[p] = *(const f32x4*)(obuf + (size_t)m * RW + c); vu4[p] = *(const u32x2*)(scanrec + rec * REC + 1024 + l16 * 8); rk4[p] = rkdot[(size_t)m * 16 + h];
                    lg4[p] = *(const f32x4*)(lng + c); lb4[p] = *(const f32x4*)(lnb + c); gg4[p] = *(const u32x2*)(hmix + (size_t)m * DM + c); }
#pragma unroll
                for (int p = 0; p < 4; ++p) {
                    const int h = p * 4 + g16, c = h * 64 + l16 * 4;
                    const f32x4 ov = ov4[p];
                    const float mu_ = sum16((ov.x + ov.y) + (ov.z + ov.w)) * (1.f / 64);
                    const f32x4 d = ov - mu_;
                    const float var = sum16((d.x * d.x + d.y * d.y) + (d.z * d.z + d.w * d.w)) * (1.f / 64);
                    const float rstd = rsqrtf(var + 64e-5f);
                    const u32x2 vu = vu4[p]; const f32x4 vv = {bflo(vu.x), bfhi(vu.x), bflo(vu.y), bfhi(vu.y)};
                    const float rk = rk4[p];
                    const f32x4 lg = lg4[p], lb = lb4[p];
                    u32x2* gp = (u32x2*)(hmix + (size_t)m * DM + c); const u32x2 gg = gg4[p];
                    const float y0 = (d.x * rstd * lg.x + lb.x + rk * vv.x) * bflo(gg.x), y1 = (d.y * rstd * lg.y + lb.y + rk * vv.y) * bfhi(gg.x);
                    const float y2 = (d.z * rstd * lg.z + lb.z + rk * vv.z) * bflo(gg.y), y3 = (d.w * rstd * lg.w + lb.w + rk * vv.w) * bfhi(gg.y);
                    u32x2 w; w.x = cvtpk(y0, y1); w.y = cvtpk(y2, y3); *gp = w;
                }
            }
        }
        if (ATT_PROBE) { SEAM(pb + 4); }
        if (IN(pb + 5) && EN(7)) {
            PHASE_LOCALS
            const float* gqn = args.in[28] + (size_t)l * 128; const float* gqr = args.in[29] + (size_t)l * ROPE;
            for (int v = bx; v < 256; v += G) {
                const int vv = (G == 256) ? ((v & 7) * 32 + (v >> 3)) : v;
                const int bh = vv >> 2, s = vv & 3, b = bh >> 4, h = bh & 15;
#pragma unroll 1
                for (int i = 0; i < 4; ++i) {
                    const int qb = (i == 0) ? 15 - s : (i == 1) ? s : (i == 2) ? 11 - s : 4 + s;
                    const size_t m0 = (size_t)b * SEQ + (size_t)qb * 256, k0 = (size_t)b * SEQ;
                    att::AUnit u{Qb + m0 * QW + h * 192, Kn + ((size_t)h * KROWS + k0) * 128, Vb + ((size_t)h * KROWS + k0) * 128, Krb + k0 * ROPE, hmix + m0 * DM + RW + h * 128, 4 * qb + 4, 8, 4 * qb, 0, qb * 256, gqn, gqr, tab};
                    att::attn_unit<0>(u, (LAS char*)lds);
                    if (ATT_PROBE) { att::AUnit u2 = u; u2.O = (bf16_t*)(ws + WS_SCAN) + (u.O - hmix); att::attn_unit<(ATT_PROBE == 4 ? 0 : ATT_PROBE)>(u2, (LAS char*)lds); }
                }
                {
                    const int sb = v >> 4, sh = v & 15;
                    const size_t m0 = (size_t)MP + (size_t)sb * DS, k0 = (size_t)MP + (size_t)sb * SKEYS;
                    att::AUnit u{Qb + m0 * QW + sh * 192, Kn + ((size_t)sh * KROWS + k0) * 128, Vb + ((size_t)sh * KROWS + k0) * 128, Krb + k0 * ROPE, hmix + m0 * DM + RW + sh * 128, 33, 1, 32, 1, PAST, gqn, gqr, tab};
                    att::attn_unit<0>(u, (LAS char*)lds);
                }
            }
        }
        SEAM(pb + 5);
        if (IN(pb + 6) && EN(8)) {
            PHASE_LOCALS
            if (G == 256) {
                { pg8::Gemm g{hmix, wtout, MP, DM, DM, 0}; pg8::StaticOrder S; S.init(MP, DM, G, bx);
                  pg8::EpiResGate E{xp, xs, out + O_YP, modf_l + 2 * DM};
                  pg8::gemm_phase<pg8::EpiResGate, pg8::StaticOrder, true, true>(lds, g, S, E); }
                { const int un = bx >> 3, ks = bx & 7;
                  pg8::Gemm g{hmix + ks * 512, wtout + ks * 512, M, DM, 512, DM}; pg8::OneUnit S{MP / 256 + (un >> 4), un & 15};
                  pg8::EpiPart E{(float*)(ws + WS_PART) + (size_t)bx * 65536};
                  pg8::gemm_phase<pg8::EpiPart, pg8::OneUnit, true, true>(lds, g, S, E); }
                if (l + 1 < DEPTH) convert_weights(args, l + 1, lds, gw, ngw, wave, lane, 5, nullptr);
                xcd_barrier(bar);
                {
                    const float* part = (const float*)(ws + WS_PART); const float* gate = modf_l + 2 * DM;
                    f32x4 ra[4], rx[4], rg[4];
#pragma unroll
                    for (int q = 0; q < 4; ++q) { const int idx = q * (G * 512) + bx * 512 + tid, r = idx >> 10, c = (idx & 1023) * 4;
                        const float* pp = part + ((size_t)(((r >> 8) * 16 + (c >> 8)) * 8) * 65536 + (size_t)(r & 255) * 256 + (c & 255));
                        f32x4 a = *(const f32x4*)pp;
#pragma unroll
                        for (int k2 = 1; k2 < 8; ++k2) a += *(const f32x4*)(pp + (size_t)k2 * 65536);
                        ra[q] = a; rx[q] = *(const f32x4*)(xs + (size_t)r * DM + c); rg[q] = *(const f32x4*)(gate + (size_t)(4 + (r >> 5)) * (3 * DM) + c); }
#pragma unroll
                    for (int q = 0; q < 4; ++q) { const int idx = q * (G * 512) + bx * 512 + tid, r = idx >> 10, c = (idx & 1023) * 4;
                        *(f32x4*)(out + O_YS + (size_t)r * DM + c) = rx[q] + rg[q] * ra[q]; }
                }
            } else {
                pg8::Gemm g{hmix, wtout, M, DM, DM, 0}; pg8::StaticOrder S; S.init(M, DM, G, bx);
                pg8::EpiResGate E{xp, xs, out + O_YP, modf_l + 2 * DM};
                pg8::gemm_phase<pg8::EpiResGate, pg8::StaticOrder, true, true>(lds, g, S, E);
                if (l + 1 < DEPTH) convert_weights(args, l + 1, lds, gw, ngw, wave, lane, 5, (unsigned*)(ws + WS_CTL) + CW_TICKET + 64 * l);
            }
        }
        SEAM(pb + 6);
    }
#undef IN
#undef SEAM
}

extern "C" void kernel_launch(void* const* d_in, const int* in_sizes, int n_in, void* d_out, int out_size, void* d_ws, size_t ws_size, hipStream_t stream) {
    static int grid = 0;
    if (grid == 0) {
        if (n_in != 35 || (size_t)out_size != O_END || ws_size < WS_END) { fprintf(stderr, "kernel_launch: shape mismatch (n_in %d, out %d, ws %zu)\n", n_in, out_size, ws_size); grid = -1; return; }
        int dev = 0, cus = 0, per_cu = 0;
        if (hipGetDevice(&dev) != hipSuccess || hipDeviceGetAttribute(&cus, hipDeviceAttributeMultiprocessorCount, dev) != hipSuccess) { grid = -1; return; }
        if (hipFuncSetAttribute((const void*)mk_fwd, hipFuncAttributeMaxDynamicSharedMemorySize, LDS_BYTES) != hipSuccess) { fprintf(stderr, "kernel_launch: hipFuncSetAttribute failed\n"); grid = -1; return; }
        if (hipOccupancyMaxActiveBlocksPerMultiprocessor(&per_cu, (const void*)mk_fwd, NWAVES * 64, LDS_BYTES) != hipSuccess || per_cu < 1) { fprintf(stderr, "kernel_launch: occupancy query reports %d\n", per_cu); }
        (void)hipGetLastError();
        grid = cus;
    }
    if (grid < 0) return;
    if (hipMemsetAsync((char*)d_ws + WS_CTL, 0, CTL_ZERO_BYTES, stream) != hipSuccess) return;
    Args a{};
    for (int i = 0; i < 35; ++i) a.in[i] = (const float*)d_in[i];
    a.out = (float*)d_out; a.ws = (unsigned char*)d_ws;
    constexpr int NL = MK_N_LAUNCHES;
    for (int li = 0; li < NL; ++li) {
        a.ph_lo = (NL == 1) ? 0 : li; a.ph_hi = (NL == 1) ? NPHASE : li + 1; a.li = li; a.pad = 0;
        hipLaunchKernelGGL(mk_fwd, dim3(grid), dim3(NWAVES * 64), LDS_BYTES, stream, a);
        const hipError_t le = hipPeekAtLastError();
        if (le != hipSuccess) { fprintf(stderr, "kernel_launch: launch %d failed: %s\n", li, hipGetErrorName(le)); break; }
    }
}
```

```cpp
#include <hip/hip_runtime.h>
#include <cstdio>
#include <cstdint>

#ifndef MK_N_LAUNCHES
#define MK_N_LAUNCHES 1
#endif

#ifndef PROBE_DUP
#define PROBE_DUP -1
#endif
#define REPS(k) ((PROBE_DUP) == (k) ? 2 : 1)
#ifndef ATT_PROBE
#define ATT_PROBE 0
#endif
#ifndef EN_MASK
#define EN_MASK 0xFFFF
#endif
#define EN(k) (((EN_MASK) >> (k)) & 1)
#define GAS __attribute__((address_space(1)))
#define LAS __attribute__((address_space(3)))
typedef unsigned short bf16_t;
typedef short bf16x8 __attribute__((ext_vector_type(8)));
typedef short s16x4 __attribute__((ext_vector_type(4)));
typedef float f32x2 __attribute__((ext_vector_type(2)));
typedef float f32x4 __attribute__((ext_vector_type(4)));
typedef float f32x16 __attribute__((ext_vector_type(16)));
typedef unsigned u32x2 __attribute__((ext_vector_type(2)));
typedef unsigned u32x4 __attribute__((ext_vector_type(4)));

constexpr int DM = 4096, NB = 4, SEQ = 4096, DEPTH = 2, DB = 16, DS = 32, PAST = 2048;
constexpr int MP = NB * SEQ, MS = DB * DS, M = MP + MS;
constexpr int RW = 1024, SHIFT_DIM = 3200, QL = 1024, KVL = 512, ROPE = 64, MLAD = 2048, CONVD = 1024;
constexpr int IN_COLS = 11968, NPAD = 12032;
constexpr int C_RWGATE = 3200, C_CQ = 4224, C_CKV = 5248, C_KR = 5760, C_MGATE = 5824, C_CVB = 7872, C_CVC = 8896, C_CVX = 9920, C_CVG = 10944;
constexpr int SKEYS = PAST + DS;
constexpr int KROWS = MP + DB * SKEYS;
constexpr int QW = 3072;
constexpr float NORM_EPS = 1e-6f;
constexpr float QSCALE = 0.07216878364870323f * 1.4426950408889634f;
constexpr int REC = 1152;
constexpr int SREC_S0 = NB * 16 * SEQ;

constexpr size_t O_YP = 0, O_YS = 67108864, O_LATP = 69206016, O_KRP = 85983232, O_RWP = 88080384, O_SHP = 88604672, O_CVP = 88630272,
                 O_LATS = 88646656, O_KRS = 89170944, O_RWS = 89236480, O_SHS = 91333632, O_CVS = 91436032, O_END = 91501568;

constexpr size_t MiB = 1u << 20;
constexpr size_t WS_CTL = 0, CTL_ZERO_BYTES = 1 * MiB;
constexpr size_t WS_TAB = 1 * MiB;
constexpr size_t WS_MODP = 2 * MiB;
constexpr size_t WS_QIN = 2 * MiB;
constexpr size_t WS_MODF = 35 * MiB;
constexpr size_t WS_RKDOT = 37 * MiB;
constexpr size_t WS_W2P = 37 * MiB + 1280 * 1024;
constexpr size_t WS_WTIN = 39 * MiB;
constexpr size_t WS_OBUF = 39 * MiB;
constexpr size_t WS_WTOUT = 133 * MiB;
constexpr size_t WS_WTUQ = 165 * MiB;
constexpr size_t WS_WTUKV = 171 * MiB;
constexpr size_t WS_HMIX = 175 * MiB;
constexpr size_t WS_PROJ = 307 * MiB;
constexpr size_t WS_KN = WS_PROJ;
constexpr size_t WS_V = WS_PROJ + (size_t)KROWS * 2048 * 2;
constexpr size_t WS_SCAN = 696 * MiB;
constexpr size_t WS_PART = 994 * MiB;
constexpr size_t WS_Q = 1092 * MiB;
constexpr size_t WS_LAT = 1191 * MiB;
constexpr size_t WS_KR = 1240 * MiB;
constexpr size_t WS_CHK = 1247 * MiB;
constexpr size_t WS_END = 1496 * MiB;
static_assert(WS_V + (size_t)(KROWS + 64) * 2048 * 2 <= WS_SCAN, "ws map");
static_assert((KROWS / 256) * (2 * MLAD / 256) == 3104 && (M / 256) * (QW / 256) == 792, "KvOrder's unit counts");
static_assert(WS_PROJ + (size_t)M * NPAD * 2 <= WS_SCAN, "ws map");
static_assert(WS_SCAN + (size_t)(SREC_S0 + DB * 16 * DS) * REC <= WS_PART && WS_PART + (size_t)32 * 8 * 65536 * 4 <= WS_Q, "ws map");
static_assert(WS_CHK + (size_t)(NB * 16 * (SEQ / 16) + DB * 16 * (DS / 16)) * 15360 <= WS_END, "ws map");
static_assert(WS_RKDOT + (size_t)M * 16 * 4 <= WS_W2P && WS_W2P + 512 * 1024 <= WS_WTIN, "ws map");
static_assert(WS_OBUF + (size_t)M * RW * 4 <= WS_WTOUT && WS_QIN + (size_t)M * QL * 2 <= WS_MODF && WS_MODP + (size_t)2 * 11 * 20 * 12288 * 4 <= WS_MODF, "ws map");

constexpr int CW_BAR = 4096;
constexpr int CW_TICKET = 2048;

__device__ __forceinline__ float bflo(unsigned u) { return __uint_as_float(u << 16); }
__device__ __forceinline__ float bfhi(unsigned u) { return __uint_as_float(u & 0xffff0000u); }
__device__ __forceinline__ float bf2f(bf16_t b) { return __uint_as_float((unsigned)b << 16); }
__device__ __forceinline__ unsigned cvtpk(float lo, float hi) { unsigned r; asm volatile("v_cvt_pk_bf16_f32 %0, %1, %2" : "=v"(r) : "v"(lo), "v"(hi)); return r; }
__device__ __forceinline__ bf16_t f2bf(float f) { return (bf16_t)(cvtpk(f, 0.f) & 0xffffu); }
__device__ __forceinline__ float wave_sum(float v) {
#pragma unroll
    for (int o = 32; o >= 1; o >>= 1) v += __shfl_xor(v, o);
    return v;
}
__device__ __forceinline__ float sum16(float v) { v += __shfl_xor(v, 1); v += __shfl_xor(v, 2); v += __shfl_xor(v, 4); v += __shfl_xor(v, 8); return v; }
template <int CTRL> __device__ __forceinline__ float dppx_(float x) { return __int_as_float(__builtin_amdgcn_update_dpp(0, __float_as_int(x), CTRL, 0xf, 0xf, true)); }
__device__ __forceinline__ float sum32(float v) {
    v += dppx_<0xB1>(v); v += dppx_<0x4E>(v); v += dppx_<0x141>(v); v += dppx_<0x140>(v); v += __shfl_xor(v, 16); return v; }
typedef __bf16 bf16x2_t __attribute__((ext_vector_type(2)));
#define DOT2(a_, b_, c_) __builtin_amdgcn_fdot2_f32_bf16(__builtin_bit_cast(bf16x2_t, (unsigned)(a_)), __builtin_bit_cast(bf16x2_t, (unsigned)(b_)), (c_), false)
__device__ __forceinline__ float sigmoidf_(float x) { return __builtin_amdgcn_rcpf(1.0f + __expf(-x)); }
__device__ __forceinline__ float siluf_(float x) { return x * __builtin_amdgcn_rcpf(1.0f + __expf(-x)); }
__device__ __forceinline__ void unpack8(u32x4 u, float* f) {
    f[0] = bflo(u.x); f[1] = bfhi(u.x); f[2] = bflo(u.y); f[3] = bfhi(u.y); f[4] = bflo(u.z); f[5] = bfhi(u.z); f[6] = bflo(u.w); f[7] = bfhi(u.w);
}
__device__ __forceinline__ u32x4 pack8(const float* f) { u32x4 w; w.x = cvtpk(f[0], f[1]); w.y = cvtpk(f[2], f[3]); w.z = cvtpk(f[4], f[5]); w.w = cvtpk(f[6], f[7]); return w; }

__constant__ float ROPE_FREQ[32] = {
    1.000000000e+00f, 7.498942614e-01f, 5.623413324e-01f, 4.216965139e-01f, 3.162277639e-01f, 2.371373773e-01f, 1.778279394e-01f, 1.333521307e-01f,
    1.000000015e-01f, 7.498941571e-02f, 5.623413250e-02f, 4.216965288e-02f, 3.162277490e-02f, 2.371373773e-02f, 1.778279431e-02f, 1.333521493e-02f,
    9.999999776e-03f, 7.498941850e-03f, 5.623413250e-03f, 4.216964822e-03f, 3.162277630e-03f, 2.371373586e-03f, 1.778279431e-03f, 1.333521446e-03f,
    1.000000047e-03f, 7.498942432e-04f, 5.623413017e-04f, 4.216965172e-04f, 3.162277571e-04f, 2.371373703e-04f, 1.778279402e-04f, 1.333521504e-04f};

namespace pg8 {
#define PG8_LAS __attribute__((address_space(3)))
constexpr int BM = 256, BK = 64, HALF = 128, HTB = HALF * BK * 2, STAGE_BYTES = 8 * HTB, NXCD = 8, WGM = 8;
__host__ __device__ __forceinline__ int lds_byte(int r, int c) { const int st = (r >> 4) * 2 + (c >> 5), rr = r & 15, cc = c & 31, ob = rr * 64 + cc * 2; return st * 1024 + (ob ^ (((ob >> 9) & 1) << 5)); }
__host__ __device__ __forceinline__ void stage_rc(int b, int& R, int& C) { const int st = b / 1024, sb = b % 1024, swz = sb ^ (((sb >> 9) & 1) << 5); R = (st >> 1) * 16 + swz / 64; C = (st & 1) * 32 + (swz % 64) / 2; }
__host__ __device__ __forceinline__ int perm32(int rho) { const int n = rho >> 4, i = rho & 15; return 8 * (i >> 2) + 4 * n + (i & 3); }

struct Unit { int pm, pn; };
struct Gemm { const bf16_t* A; const bf16_t* Bt; int M, N, K; int ld; };

struct StaticOrder {
    int nM, nN, nwg, G, c;
    __host__ __device__ void init(int M_, int N_, int G_, int c_) { nM = M_ / BM; nN = N_ / BM; nwg = nM * nN; G = G_; c = c_; }
    __host__ __device__ bool next(int i, Unit& u) const {
        const long L = (long)i * G + c; if (L >= nwg) return false;
        int wgid = (int)L; { const int q = nwg / NXCD, r = nwg % NXCD, xcd = wgid % NXCD, off = wgid / NXCD; wgid = (xcd < r ? xcd * (q + 1) : r * (q + 1) + (xcd - r) * q) + off; }
        const int nig = WGM * nN, gid = wgid / nig, fm = gid * WGM, gsz = (nM - fm) < WGM ? (nM - fm) : WGM;
        u.pm = fm + ((wgid % nig) % gsz); u.pn = (wgid % nig) / gsz; return true;
    }
    __device__ __forceinline__ void a_ready(const Unit&) const {}
    __device__ __forceinline__ void done(const Unit&) const {}
};
struct KvOrder {
    int nM, nN, nwg, bx;
    __host__ __device__ void init(int M_, int N_, int bx_) { nM = M_ / BM; nN = N_ / BM; nwg = nM * nN; bx = bx_; }
    __host__ __device__ bool next(int i, Unit& u) const {
        const int gc = bx - 64; int L;
        if (i < 8) L = 256 * i + bx;
        else if (gc < 0) return false;
        else if (i < 12) L = 2048 + 192 * (i - 8) + gc;
        else if (gc < 24) return false;
        else if (i == 12) L = 2816 + (gc - 24);
        else if (i == 13 && gc - 24 < 120) L = 2984 + (gc - 24);
        else return false;
        int wgid = L; { const int q = nwg / NXCD, r = nwg % NXCD, xcd = wgid % NXCD, off = wgid / NXCD; wgid = (xcd < r ? xcd * (q + 1) : r * (q + 1) + (xcd - r) * q) + off; }
        const int nig = WGM * nN, gid = wgid / nig, fm = gid * WGM, gsz = (nM - fm) < WGM ? (nM - fm) : WGM;
        u.pm = fm + ((wgid % nig) % gsz); u.pn = (wgid % nig) / gsz; return true;
    }
    __device__ __forceinline__ void a_ready(const Unit&) const {}
    __device__ __forceinline__ void done(const Unit&) const {}
};

struct OneUnit {
    int pm, pn;
    __host__ __device__ bool next(int i, Unit& u) const { if (i) return false; u.pm = pm; u.pn = pn; return true; }
    __device__ __forceinline__ void a_ready(const Unit&) const {}
    __device__ __forceinline__ void done(const Unit&) const {}
};
struct EpiBf16 {
    static constexpr bool PERM = true, AFTER_DRAIN = false;
    bf16_t* O; int ldc; int split_cols; size_t split_stride;
    __device__ __forceinline__ void operator()(const f32x4 (&acc)[2][2][4][2], const Unit& u, int wr, int wc, int fr, int fq) const {
        const int row0 = u.pm * BM + wr * 64 + fr; int colt = u.pn * BM; bf16_t* base = O;
        if (split_cols) { const int t = colt / split_cols; base += (size_t)t * split_stride; colt -= t * split_cols; }
        const int col0 = colt + wc * 32 + 8 * fq;
#pragma unroll
        for (int ai = 0; ai < 2; ++ai)
#pragma unroll
            for (int m = 0; m < 4; ++m) { bf16_t* rowp = base + (size_t)(row0 + ai * HALF + m * 16) * ldc + col0;
#pragma unroll
                for (int bj = 0; bj < 2; ++bj) { const f32x4 v0 = acc[ai][bj][m][0], v1 = acc[ai][bj][m][1];
                    u32x4 w; w.x = cvtpk(v0[0], v0[1]); w.y = cvtpk(v0[2], v0[3]); w.z = cvtpk(v1[0], v1[1]); w.w = cvtpk(v1[2], v1[3]);
                    *(u32x4*)(rowp + bj * HALF) = w; } }
    }
};
struct EpiKV {
    static constexpr bool PERM = true, AFTER_DRAIN = false;
    bf16_t* Kn; bf16_t* V; const float* g; PG8_LAS float* xl;
    __device__ __forceinline__ void operator()(const f32x4 (&acc)[2][2][4][2], const Unit& u, int wr, int wc, int fr, int fq) const {
        const int row0 = u.pm * BM + wr * 64 + fr; const int colt = u.pn * BM;
        if (colt >= MLAD) {
            const int head0 = (colt - MLAD) >> 7;
            bf16_t* base = V + wc * 32 + 8 * fq;
#pragma unroll
            for (int ai = 0; ai < 2; ++ai)
#pragma unroll
                for (int m = 0; m < 4; ++m) { const size_t r = (size_t)(row0 + ai * HALF + m * 16);
#pragma unroll
                    for (int bj = 0; bj < 2; ++bj) { const f32x4 v0 = acc[ai][bj][m][0], v1 = acc[ai][bj][m][1];
                        u32x4 w; w.x = cvtpk(v0[0], v0[1]); w.y = cvtpk(v0[2], v0[3]); w.z = cvtpk(v1[0], v1[1]); w.w = cvtpk(v1[2], v1[3]);
                        *(u32x4*)(base + ((size_t)(head0 + bj) * KROWS + r) * 128) = w; } }
            return;
        }
        float ss[2][4][2];
#pragma unroll
        for (int ai = 0; ai < 2; ++ai)
#pragma unroll
            for (int m = 0; m < 4; ++m)
#pragma unroll
                for (int bj = 0; bj < 2; ++bj) { const f32x4 v0 = acc[ai][bj][m][0], v1 = acc[ai][bj][m][1];
                    float a = (v0[0] * v0[0] + v0[1] * v0[1]) + (v0[2] * v0[2] + v0[3] * v0[3]) + (v1[0] * v1[0] + v1[1] * v1[1]) + (v1[2] * v1[2] + v1[3] * v1[3]);
                    a += __shfl_xor(a, 16); a += __shfl_xor(a, 32);
                    ss[ai][m][bj] = a; }
        PG8_LAS float* mine = xl + (wr * 4 + wc) * 256;
        if (fq == 0) {
#pragma unroll
            for (int ai = 0; ai < 2; ++ai)
#pragma unroll
                for (int m = 0; m < 4; ++m)
#pragma unroll
                    for (int bj = 0; bj < 2; ++bj) mine[((ai * 4 + m) * 2 + bj) * 16 + fr] = ss[ai][m][bj];
        }
        asm volatile("s_waitcnt lgkmcnt(0)" ::: "memory"); __builtin_amdgcn_s_barrier(); asm volatile("" ::: "memory");
        const int colh = wc * 32 + 8 * fq;
        const f32x4 g0 = *(const f32x4*)(g + colh), g1 = *(const f32x4*)(g + colh + 4);
        const int head0 = colt >> 7;
        bf16_t* base = Kn + colh;
#pragma unroll
        for (int ai = 0; ai < 2; ++ai)
#pragma unroll
            for (int m = 0; m < 4; ++m) { const size_t r = (size_t)(row0 + ai * HALF + m * 16);
#pragma unroll
                for (int bj = 0; bj < 2; ++bj) {
                    const int slot = ((ai * 4 + m) * 2 + bj) * 16 + fr;
                    const float tot = (xl[(wr * 4 + 0) * 256 + slot] + xl[(wr * 4 + 1) * 256 + slot]) + (xl[(wr * 4 + 2) * 256 + slot] + xl[(wr * 4 + 3) * 256 + slot]);
                    const float rs = rsqrtf(tot * (1.f / 128) + NORM_EPS);
                    const f32x4 v0 = acc[ai][bj][m][0] * rs * g0, v1 = acc[ai][bj][m][1] * rs * g1;
                    u32x4 w; w.x = cvtpk(v0[0], v0[1]); w.y = cvtpk(v0[2], v0[3]); w.z = cvtpk(v1[0], v1[1]); w.w = cvtpk(v1[2], v1[3]);
                    *(u32x4*)(base + ((size_t)(head0 + bj) * KROWS + r) * 128) = w; } }
    }
};
struct EpiPart {
    static constexpr bool PERM = false, AFTER_DRAIN = false;
    float* P;
    __device__ __forceinline__ void operator()(const f32x4 (&acc)[2][2][4][2], const Unit&, int wr, int wc, int fr, int fq) const {
        const int col0 = wc * 32 + 4 * fq;
#pragma unroll
        for (int ai = 0; ai < 2; ++ai)
#pragma unroll
            for (int m = 0; m < 4; ++m) { float* prow = P + (size_t)(ai * HALF + wr * 64 + m * 16 + fr) * BM + col0;
#pragma unroll
                for (int bj = 0; bj < 2; ++bj)
#pragma unroll
                    for (int n = 0; n < 2; ++n) *(f32x4*)(prow + bj * HALF + n * 16) = acc[ai][bj][m][n]; }
    }
};
struct EpiResGate {
    static constexpr bool PERM = false, AFTER_DRAIN = false;
    const float* xp; const float* xs; float* out; const float* gate;
    __device__ __forceinline__ void operator()(const f32x4 (&acc)[2][2][4][2], const Unit& u, int wr, int wc, int fr, int fq) const {
        const int col0 = u.pn * BM + wc * 32 + 4 * fq;
#pragma unroll
        for (int ai = 0; ai < 2; ++ai)
#pragma unroll
            for (int mp = 0; mp < 2; ++mp) {
                f32x4 xv8[8], gv8[8];
#pragma unroll
                for (int q = 0; q < 8; ++q) { const int m = 2 * mp + (q >> 2), r = u.pm * BM + ai * HALF + wr * 64 + m * 16 + fr, c = col0 + ((q >> 1) & 1) * HALF + (q & 1) * 16;
                    const int seq = r < MP ? (r >> 12) : 4 + ((r - MP) >> 5);
                    const float* xr = r < MP ? xp + (size_t)r * DM : xs + (size_t)(r - MP) * DM;
                    xv8[q] = *(const f32x4*)(xr + c); gv8[q] = *(const f32x4*)(gate + (size_t)seq * (3 * DM) + c); }
#pragma unroll
                for (int q = 0; q < 8; ++q) { const int m = 2 * mp + (q >> 2), r = u.pm * BM + ai * HALF + wr * 64 + m * 16 + fr, c = col0 + ((q >> 1) & 1) * HALF + (q & 1) * 16;
                    *(f32x4*)(out + (size_t)r * DM + c) = xv8[q] + gv8[q] * acc[ai][(q >> 1) & 1][m][q & 1]; }
            }
    }
};

template <class Epi, class Sched, bool ALIGN_EPI = false, bool SP2 = false>
__device__ __forceinline__ void gemm_phase(PG8_LAS unsigned char* lds, const Gemm g, const Sched& S, const Epi& E) {
    int tid_ = threadIdx.x; asm volatile("" : "+v"(tid_));
    const int tid = tid_, wid = __builtin_amdgcn_readfirstlane(tid >> 6), lane = tid & 63, wr = wid >> 2, wc = wid & 3, fr = lane & 15, fq = lane >> 4;
    const int K = g.K, LD = g.ld ? g.ld : g.K, nt = K / BK;
    unsigned voffA[2], voffB[2];
#pragma unroll
    for (int i = 0; i < 2; ++i) { int R, C; stage_rc(tid * 16 + i * 8192, R, C); const int Rb = Epi::PERM ? ((R & ~31) + perm32(R & 31)) : R;
        voffA[i] = (unsigned)(R * LD + C) * 2u; voffB[i] = (unsigned)(Rb * LD + C) * 2u; }
    const size_t kstep = (size_t)(BK * 2);
    const size_t hstep = (size_t)HALF * LD * 2;
    const size_t tstep = 2 * hstep;
    const unsigned ldsw = (unsigned)wid * 1024u;
    const int aoff = lds_byte(wr * 64 + fr, fq * 8), boff = lds_byte(wc * 32 + fr, fq * 8);
#define PG8_SA(b, h) (((b) * 2 + (h)) * HTB)
#define PG8_SB(b, h) ((4 + (b) * 2 + (h)) * HTB)
#define PG8_STAGE(bufoff, gbase, voff) do { _Pragma("unroll") for (int _i = 0; _i < 2; ++_i) \
        __builtin_amdgcn_global_load_lds((const unsigned*)((const char*)(gbase) + (voff)[_i]), (PG8_LAS unsigned*)(lds + (bufoff) + ldsw + _i * 8192), 16, 0, 0); } while (0)
#define PG8_LDA(dst, b, h) do { _Pragma("unroll") for (int m = 0; m < 4; ++m) _Pragma("unroll") for (int k = 0; k < 2; ++k) dst[m][k] = *(const PG8_LAS bf16x8*)(lds + PG8_SA(b, h) + aoff + m * 2048 + k * 1024); } while (0)
#define PG8_LDB(dst, b, h) do { _Pragma("unroll") for (int n = 0; n < 2; ++n) _Pragma("unroll") for (int k = 0; k < 2; ++k) dst[n][k] = *(const PG8_LAS bf16x8*)(lds + PG8_SB(b, h) + boff + n * 2048 + k * 1024); } while (0)
#define PG8_MMA(ai, bj, At, Bt) do { __builtin_amdgcn_s_setprio(1); _Pragma("unroll") for (int m = 0; m < 4; ++m) _Pragma("unroll") for (int n = 0; n < 2; ++n) _Pragma("unroll") for (int k = 0; k < 2; ++k) \
        acc[ai][bj][m][n] = __builtin_amdgcn_mfma_f32_16x16x32_bf16(Bt[n][k], At[m][k], acc[ai][bj][m][n], 0, 0, 0); __builtin_amdgcn_s_setprio(0); } while (0)
#define PG8_WAIT_V(n) asm volatile("s_waitcnt vmcnt(" #n ")" ::: "memory")
#define PG8_WAIT_L(n) asm volatile("s_waitcnt lgkmcnt(" #n ")" ::: "memory")
#define PG8_BAR __builtin_amdgcn_s_barrier()
#define PG8_SCHED __builtin_amdgcn_sched_barrier(0)
    Unit cur, nxt; int ui = 0;
    if (!S.next(0, cur)) return;
    f32x4 acc[2][2][4][2];
#pragma unroll
    for (int a = 0; a < 2; ++a)
#pragma unroll
        for (int b = 0; b < 2; ++b)
#pragma unroll
            for (int m = 0; m < 4; ++m)
#pragma unroll
                for (int n = 0; n < 2; ++n) acc[a][b][m][n] = (f32x4){0.f, 0.f, 0.f, 0.f};
    bf16x8 At[4][2], B0[2][2], B1[2][2];
    const char* cA = (const char*)g.A + (size_t)cur.pm * tstep; const char* cB = (const char*)g.Bt + (size_t)cur.pn * tstep;
    S.a_ready(cur);
    if constexpr (SP2) {
        PG8_STAGE(PG8_SB(0, 0), cB, voffB); PG8_STAGE(PG8_SB(0, 1), cB + hstep, voffB); PG8_STAGE(PG8_SA(0, 0), cA, voffA); PG8_STAGE(PG8_SA(0, 1), cA + hstep, voffA);
        if (wr == 1) PG8_BAR;
        PG8_WAIT_V(2); PG8_BAR;
        PG8_STAGE(PG8_SB(1, 0), cB + kstep, voffB); PG8_STAGE(PG8_SA(1, 0), cA + kstep, voffA); PG8_STAGE(PG8_SB(1, 1), cB + hstep + kstep, voffB);
        PG8_WAIT_V(6); PG8_BAR;
    } else {
        PG8_STAGE(PG8_SB(0, 0), cB, voffB); PG8_STAGE(PG8_SA(0, 0), cA, voffA); PG8_STAGE(PG8_SB(0, 1), cB + hstep, voffB); PG8_STAGE(PG8_SA(0, 1), cA + hstep, voffA);
        if (wr == 1) PG8_BAR;
        PG8_WAIT_V(4); PG8_BAR;
        PG8_STAGE(PG8_SB(1, 0), cB + kstep, voffB); PG8_STAGE(PG8_SA(1, 0), cA + kstep, voffA); PG8_STAGE(PG8_SB(1, 1), cB + hstep + kstep, voffB);
        PG8_WAIT_V(6); PG8_BAR;
    }
    for (;;) {
        const bool has_next = S.next(ui + 1, nxt);
        const char* nA = has_next ? (const char*)g.A + (size_t)nxt.pm * tstep : cA; const char* nB = has_next ? (const char*)g.Bt + (size_t)nxt.pn * tstep : cB;
        for (int t = 0; t < nt; t += 2) {
            const bool last = (t == nt - 2);
            const char* a1 = cA + (size_t)(t + 1) * kstep;
            const char* a2 = last ? nA : cA + (size_t)(t + 2) * kstep; const char* b2 = last ? nB : cB + (size_t)(t + 2) * kstep;
            const char* a3 = a2 + kstep; const char* b3 = b2 + kstep;
            if (last && has_next) S.a_ready(nxt);
            if constexpr (SP2) {
            PG8_LDB(B0, 0, 0); PG8_LDB(B1, 0, 1); PG8_SCHED; PG8_LDA(At, 0, 0); PG8_STAGE(PG8_SA(1, 1), a1 + hstep, voffA);
            PG8_WAIT_V(8); PG8_WAIT_L(0); PG8_BAR; PG8_MMA(0, 0, At, B0); PG8_MMA(0, 1, At, B1); PG8_BAR; PG8_SCHED;
            PG8_LDA(At, 0, 1); PG8_STAGE(PG8_SB(0, 0), b2, voffB); PG8_STAGE(PG8_SB(0, 1), b2 + hstep, voffB); PG8_STAGE(PG8_SA(0, 0), a2, voffA);
            PG8_WAIT_V(8); PG8_WAIT_L(0); PG8_BAR; PG8_MMA(1, 0, At, B0); PG8_MMA(1, 1, At, B1); PG8_BAR; PG8_SCHED;
            PG8_LDB(B0, 1, 0); PG8_LDB(B1, 1, 1); PG8_SCHED; PG8_LDA(At, 1, 0); PG8_STAGE(PG8_SA(0, 1), a2 + hstep, voffA);
            PG8_WAIT_V(8); PG8_WAIT_L(0); PG8_BAR; PG8_MMA(0, 0, At, B0); PG8_MMA(0, 1, At, B1); PG8_BAR; PG8_SCHED;
            PG8_LDA(At, 1, 1); PG8_STAGE(PG8_SB(1, 0), b3, voffB); PG8_STAGE(PG8_SB(1, 1), b3 + hstep, voffB); PG8_STAGE(PG8_SA(1, 0), a3, voffA);
            PG8_WAIT_V(8); PG8_WAIT_L(0); PG8_BAR; PG8_MMA(1, 0, At, B0); PG8_MMA(1, 1, At, B1); PG8_BAR; PG8_SCHED;
            } else {
            PG8_LDB(B0, 0, 0); PG8_SCHED; PG8_LDA(At, 0, 0); PG8_STAGE(PG8_SA(1, 1), a1 + hstep, voffA);
            PG8_WAIT_L(8); PG8_BAR; PG8_WAIT_L(0); PG8_MMA(0, 0, At, B0); PG8_BAR; PG8_SCHED;
            PG8_LDB(B1, 0, 1); PG8_STAGE(PG8_SB(0, 0), b2, voffB);
            PG8_BAR; PG8_WAIT_L(0); PG8_MMA(0, 1, At, B1); PG8_BAR;
            PG8_LDA(At, 0, 1); PG8_STAGE(PG8_SA(0, 0), a2, voffA);
            PG8_BAR; PG8_WAIT_L(0); PG8_MMA(1, 0, At, B0); PG8_BAR; PG8_SCHED;
            PG8_STAGE(PG8_SB(0, 1), b2 + hstep, voffB);
            PG8_WAIT_V(6); PG8_BAR; PG8_MMA(1, 1, At, B1); PG8_BAR;
            PG8_LDB(B0, 1, 0); PG8_SCHED; PG8_LDA(At, 1, 0); PG8_STAGE(PG8_SA(0, 1), a2 + hstep, voffA);
            PG8_WAIT_L(8); PG8_BAR; PG8_WAIT_L(0); PG8_MMA(0, 0, At, B0); PG8_BAR; PG8_SCHED;
            PG8_LDB(B1, 1, 1); PG8_STAGE(PG8_SB(1, 0), b3, voffB);
            PG8_BAR; PG8_WAIT_L(0); PG8_MMA(0, 1, At, B1); PG8_BAR;
            PG8_LDA(At, 1, 1); PG8_STAGE(PG8_SA(1, 0), a3, voffA);
            PG8_BAR; PG8_WAIT_L(0); PG8_MMA(1, 0, At, B0); PG8_BAR; PG8_SCHED;
            PG8_STAGE(PG8_SB(1, 1), b3 + hstep, voffB);
            PG8_WAIT_V(6); PG8_BAR; PG8_MMA(1, 1, At, B1); PG8_BAR;
            }
        }
        if constexpr (ALIGN_EPI) { if (wr == 0) PG8_BAR; }
        if constexpr (!Epi::AFTER_DRAIN) { E(acc, cur, wr, wc, fr, fq); S.done(cur); }
        if (!has_next) break;
#pragma unroll
        for (int a = 0; a < 2; ++a)
#pragma unroll
            for (int b = 0; b < 2; ++b)
#pragma unroll
                for (int m = 0; m < 4; ++m)
#pragma unroll
                    for (int n = 0; n < 2; ++n) acc[a][b][m][n] = (f32x4){0.f, 0.f, 0.f, 0.f};
        cur = nxt; cA = nA; cB = nB; ++ui;
        if constexpr (ALIGN_EPI) { if (wr == 1) PG8_BAR; }
    }
    PG8_WAIT_V(0);
    if constexpr (!ALIGN_EPI) { if (wr == 0) PG8_BAR; }
    PG8_BAR;
#undef PG8_SA
#undef PG8_SB
#undef PG8_STAGE
#undef PG8_LDA
#undef PG8_LDB
#undef PG8_MMA
#undef PG8_WAIT_V
#undef PG8_WAIT_L
#undef PG8_BAR
#undef PG8_SCHED
}
}

#define XB_TMO      128
#define XB_XCNT(j)  (256  + 64 * (j))
#define XB_XSUB(j)  (1280 + 64 * (j))
#define XB_XGEN(j)  (2304 + 64 * (j))
#define XB_TOP      3328
#define XB_TOPGEN   3392
#define XCD_BAR_WORDS 3456
#define XB_SPIN_CAP (1u << 18)
__device__ __forceinline__ unsigned xb_ld(unsigned* p)              { return __hip_atomic_load(p, __ATOMIC_RELAXED, __HIP_MEMORY_SCOPE_AGENT); }
__device__ __forceinline__ unsigned xb_add(unsigned* p, unsigned v) { return __hip_atomic_fetch_add(p, v, __ATOMIC_RELAXED, __HIP_MEMORY_SCOPE_AGENT); }
__device__ __forceinline__ unsigned xb_xcc_id() { return (unsigned)__builtin_amdgcn_s_getreg((3 << 11) | 20) & 0xFu; }
#define XB_SPIN(cond, bar) do { unsigned _sp = 0; while (cond) { __builtin_amdgcn_s_sleep(1); \
    if ((++_sp & 255u) == 0u) { if (xb_ld(&(bar)[XB_TMO])) break; if (_sp > XB_SPIN_CAP) { atomicAdd(&(bar)[XB_TMO], 1u); break; } } } } while (0)
struct XcdBarrier { unsigned* bar; unsigned x; volatile LAS unsigned* st; };
__device__ __forceinline__ XcdBarrier xcd_barrier_post(unsigned* bar, volatile LAS unsigned* st) {
    XcdBarrier b; b.bar = bar; b.x = xb_xcc_id(); b.st = st;
    if (threadIdx.x == 0) (void)xb_add(&bar[XB_XCNT(b.x)], 1u);
    return b;
}
__device__ __forceinline__ void xcd_barrier_complete(unsigned* bar, unsigned x, unsigned& nloc, unsigned& nx) {
    const unsigned G = gridDim.x * gridDim.y * gridDim.z;
    unsigned sum, cnt, mine, sp = 0u;
    for (;;) {
        sum = 0u; cnt = 0u; mine = 0u;
#pragma unroll
        for (unsigned j = 0; j < 16; ++j) { const unsigned c = xb_ld(&bar[XB_XCNT(j)]); sum += c; cnt += (c > 0u) ? 1u : 0u; mine = (j == x) ? c : mine; }
        if (sum == G) break;
        __builtin_amdgcn_s_sleep(1);
        if ((++sp & 255u) == 0u) { if (xb_ld(&bar[XB_TMO])) break; if (sp > XB_SPIN_CAP) { atomicAdd(&bar[XB_TMO], 1u); break; } }
    }
    nloc = mine > 0u ? mine : 1u; nx = cnt > 0u ? cnt : 1u;
}
__device__ __forceinline__ void xcd_barrier(const XcdBarrier& b) {
    asm volatile("s_waitcnt vmcnt(0)" ::: "memory");
    __syncthreads();
    if (threadIdx.x == 0) {
        unsigned* bar = b.bar;
        __builtin_amdgcn_s_waitcnt(0);
        unsigned nloc = b.st[0], nx = b.st[1];
        if (nloc == 0u) { xcd_barrier_complete(bar, b.x, nloc, nx); b.st[0] = nloc; b.st[1] = nx; }
        const unsigned old = xb_add(&bar[XB_XSUB(b.x)], 1u);
        const unsigned gen = old / nloc;
        if (old + 1u == (gen + 1u) * nloc) {
            __builtin_amdgcn_fence(__ATOMIC_RELEASE, "agent");
            asm volatile("s_waitcnt vmcnt(0)" ::: "memory");
            const unsigned og = xb_add(&bar[XB_TOP], 1u);
            const unsigned tg = og / nx;
            if (og + 1u == (tg + 1u) * nx) xb_add(&bar[XB_TOPGEN], 1u);
            else XB_SPIN(xb_ld(&bar[XB_TOPGEN]) == tg, bar);
            __builtin_amdgcn_fence(__ATOMIC_ACQUIRE, "agent");
            xb_add(&bar[XB_XGEN(b.x)], 1u);
            asm volatile("s_waitcnt vmcnt(0)" ::: "memory");
        } else {
            XB_SPIN(xb_ld(&bar[XB_XGEN(b.x)]) == gen, bar);
            __builtin_amdgcn_fence(__ATOMIC_ACQUIRE, "agent");
            asm volatile("s_waitcnt vmcnt(0)" ::: "memory");
        }
    }
    __syncthreads();
}

namespace att {
constexpr int SHM_V = 16384, SHM_KN = 16384, SHM_KR = 8192, KSTRIDE = SHM_KN + SHM_KR;
constexpr int OFF_V = 0, OFF_K = 2 * SHM_V, OFF_WS = OFF_K + 2 * KSTRIDE, LDS_BYTES = OFF_WS + 8 * 64 * 4;
#define KSWZ(row, colB) ((row) * 256 + ((colB) ^ (((row) & 15) << 4)))
#define KRSWZ(row, colB) ((row) * 128 + ((colB) ^ ((((row) >> 1) & 7) << 4)))
#define SBAR() __builtin_amdgcn_sched_barrier(0)
__device__ __forceinline__ int v_st(int k, int c) { const int kk = (k & ~0xC) | ((k & 4) << 1) | ((k & 8) >> 1); return ((kk >> 3) * 4 + (c >> 5)) * 512 + ((kk & 7) * 32 + (c & 31)) * 2; }
__device__ __forceinline__ int v_rd_base(int lane) { return ((lane & 3) << 3) | (((lane >> 2) & 3) << 6) | (((lane >> 4) & 1) << 5) | (((lane >> 5) & 1) << 8); }
constexpr int v_rd_off(int d0, int ks, int half) { return d0 * 512 + ks * 4096 + half * 2048; }
__device__ __forceinline__ int crow(int r, int hi) { return (r & 3) + 8 * (r >> 2) + 4 * hi; }

struct AUnit { const bf16_t* Q; const bf16_t* Kn; const bf16_t* V; const bf16_t* Kr; bf16_t* O; int nt, nwav, jbase, lastmask; int pos0; const float* gqn; const float* gqr; const float2* tab; };

template <int KB>
__device__ __forceinline__ void qkt(f32x16& p0, f32x16& p1, LAS const char* lds, int r32, int hi, const bf16x8* qr) {
    p0 = f32x16{}; p1 = f32x16{};
    LAS const char* kn = lds + OFF_K + KB * KSTRIDE;
    LAS const char* kr = kn + SHM_KN;
#pragma unroll
    for (int d0 = 0; d0 < 8; ++d0) {
        LAS const char* a = kn + KSWZ(r32, (d0 * 16 + hi * 8) * 2);
        const bf16x8 b0 = *(LAS const bf16x8*)a;
        const bf16x8 b1 = *(LAS const bf16x8*)(a + 32 * 256);
        p0 = __builtin_amdgcn_mfma_f32_32x32x16_bf16(b0, qr[d0], p0, 0, 0, 0);
        p1 = __builtin_amdgcn_mfma_f32_32x32x16_bf16(b1, qr[d0], p1, 0, 0, 0);
    }
#pragma unroll
    for (int d0 = 0; d0 < 4; ++d0) {
        LAS const char* a = kr + KRSWZ(r32, (d0 * 16 + hi * 8) * 2);
        const bf16x8 b0 = *(LAS const bf16x8*)a;
        const bf16x8 b1 = *(LAS const bf16x8*)(a + 32 * 128);
        p0 = __builtin_amdgcn_mfma_f32_32x32x16_bf16(b0, qr[8 + d0], p0, 0, 0, 0);
        p1 = __builtin_amdgcn_mfma_f32_32x32x16_bf16(b1, qr[8 + d0], p1, 0, 0, 0);
    }
}
template <int VB>
__device__ __forceinline__ void pv_tile(f32x16* o, int vb0, bf16x8 pa0, bf16x8 pa1, bf16x8 pa2, bf16x8 pa3) {
#define TRRD(dst, off) asm volatile("ds_read_b64_tr_b16 %0, %1 offset:%2" : "=&v"(dst) : "v"(vb0), "i"(off) : "memory")
#define PV_D0(d0) do { s16x4 l0, l1, l2, l3, h0, h1, h2, h3; constexpr int b_ = OFF_V + VB * SHM_V + v_rd_off(d0, 0, 0); \
        TRRD(l0, b_); TRRD(h0, b_ + 2048); TRRD(l1, b_ + 4096); TRRD(h1, b_ + 6144); TRRD(l2, b_ + 8192); TRRD(h2, b_ + 10240); TRRD(l3, b_ + 12288); TRRD(h3, b_ + 14336); \
        asm volatile("s_waitcnt lgkmcnt(0)" ::: "memory"); SBAR(); \
        o[d0] = __builtin_amdgcn_mfma_f32_32x32x16_bf16(pa0, (bf16x8){l0[0], l0[1], l0[2], l0[3], h0[0], h0[1], h0[2], h0[3]}, o[d0], 0, 0, 0);   \
        o[d0] = __builtin_amdgcn_mfma_f32_32x32x16_bf16(pa1, (bf16x8){l1[0], l1[1], l1[2], l1[3], h1[0], h1[1], h1[2], h1[3]}, o[d0], 0, 0, 0);   \
        o[d0] = __builtin_amdgcn_mfma_f32_32x32x16_bf16(pa2, (bf16x8){l2[0], l2[1], l2[2], l2[3], h2[0], h2[1], h2[2], h2[3]}, o[d0], 0, 0, 0);   \
        o[d0] = __builtin_amdgcn_mfma_f32_32x32x16_bf16(pa3, (bf16x8){l3[0], l3[1], l3[2], l3[3], h3[0], h3[1], h3[2], h3[3]}, o[d0], 0, 0, 0); } while (0)
    PV_D0(0); PV_D0(1); PV_D0(2); PV_D0(3);
#undef PV_D0
#undef TRRD
}

template <int VAR>
__device__ __forceinline__ void attn_unit(const AUnit& u, LAS char* lds) {
    int tid_ = threadIdx.x; asm volatile("" : "+v"(tid_));
    const int tid = tid_, wid = __builtin_amdgcn_readfirstlane(tid >> 6), lane = tid & 63, r32 = lane & 31, hi = lane >> 5;
    const bool wact = wid < u.nwav;
    const int jmax = u.jbase + (wid >> 1);
    const bf16_t* gk0; const bf16_t* gk1; const bf16_t* gkr; const bf16_t* gv0; const bf16_t* gv1;
    {
        const int rk0 = (2 * wid) * 4 + (lane >> 4), rk1 = rk0 + 4, ph = lane & 15;
        gk0 = u.Kn + (size_t)rk0 * 128 + ((ph ^ (rk0 & 15)) * 8);
        gk1 = u.Kn + (size_t)rk1 * 128 + ((ph ^ (rk1 & 15)) * 8);
        const int rr0 = wid * 8 + (lane >> 3), pr = lane & 7;
        gkr = u.Kr + (size_t)rr0 * ROPE + ((pr ^ ((rr0 >> 1) & 7)) * 8);
#pragma unroll
        for (int i = 0; i < 2; ++i) {
            const int st = (2 * wid + i) * 2 + (lane >> 5), o16 = lane & 31, kk = (st >> 2) * 8 + (o16 >> 2), c = (st & 3) * 32 + (o16 & 3) * 8;
            const int key = (kk & ~0xC) | ((kk & 4) << 1) | ((kk & 8) >> 1);
            const bf16_t* p = u.V + (size_t)key * 128 + c;
            if (i == 0) gv0 = p; else gv1 = p;
        }
    }
#define ADMA(t, bf) do { const size_t ro = (size_t)(t) * 64; LAS char* kb_ = lds + OFF_K + (bf) * KSTRIDE; LAS char* vb_ = lds + OFF_V + (bf) * SHM_V; \
        __builtin_amdgcn_global_load_lds((const unsigned*)(gk0 + ro * 128), (LAS unsigned*)(kb_ + (2 * wid) * 1024), 16, 0, 0); \
        __builtin_amdgcn_global_load_lds((const unsigned*)(gk1 + ro * 128), (LAS unsigned*)(kb_ + (2 * wid + 1) * 1024), 16, 0, 0); \
        __builtin_amdgcn_global_load_lds((const unsigned*)(gkr + ro * ROPE), (LAS unsigned*)(kb_ + SHM_KN + wid * 1024), 16, 0, 0); \
        __builtin_amdgcn_global_load_lds((const unsigned*)(gv0 + ro * 128), (LAS unsigned*)(vb_ + (2 * wid) * 1024), 16, 0, 0); \
        __builtin_amdgcn_global_load_lds((const unsigned*)(gv1 + ro * 128), (LAS unsigned*)(vb_ + (2 * wid + 1) * 1024), 16, 0, 0); } while (0)
#define AWAITV() asm volatile("s_waitcnt vmcnt(0)" ::: "memory")
    ADMA(0, 0);
    bf16x8 qr[12];
    {
        const int wq = wact ? wid : 0;
        const bf16_t* qp = u.Q + (size_t)(wq * 32 + r32) * QW + hi * 8;
#pragma unroll
        for (int d0 = 0; d0 < 12; ++d0) qr[d0] = *(const bf16x8*)(qp + d0 * 16);
        float ssn = 0.f, ssr = 0.f;
#pragma unroll
        for (int d0 = 0; d0 < 12; ++d0) { float f[8]; unpack8(__builtin_bit_cast(u32x4, qr[d0]), f); float a = 0.f;
#pragma unroll
            for (int e = 0; e < 8; ++e) a += f[e] * f[e];
            if (d0 < 8) ssn += a; else ssr += a; }
        { auto rr = __builtin_amdgcn_permlane32_swap(__float_as_uint(ssn), __float_as_uint(ssn), false, false); ssn = __uint_as_float(rr[0]) + __uint_as_float(rr[1]); }
        { auto rr = __builtin_amdgcn_permlane32_swap(__float_as_uint(ssr), __float_as_uint(ssr), false, false); ssr = __uint_as_float(rr[0]) + __uint_as_float(rr[1]); }
        const float rn = rsqrtf(ssn * (1.f / 128) + NORM_EPS) * QSCALE, rr_ = rsqrtf(ssr * (1.f / ROPE) + NORM_EPS);
#pragma unroll
        for (int d0 = 0; d0 < 8; ++d0) { float f[8]; unpack8(__builtin_bit_cast(u32x4, qr[d0]), f);
            const f32x4 g0 = *(const f32x4*)(u.gqn + d0 * 16 + hi * 8), g1 = *(const f32x4*)(u.gqn + d0 * 16 + hi * 8 + 4);
#pragma unroll
            for (int e = 0; e < 4; ++e) { f[e] *= rn * g0[e]; f[4 + e] *= rn * g1[e]; }
            qr[d0] = __builtin_bit_cast(bf16x8, pack8(f)); }
        const int pos = u.pos0 + wq * 32 + r32;
#pragma unroll
        for (int a = 0; a < 2; ++a) { float x1[8], x2[8]; unpack8(__builtin_bit_cast(u32x4, qr[8 + a]), x1); unpack8(__builtin_bit_cast(u32x4, qr[10 + a]), x2);
            const int i0 = a * 16 + hi * 8;
            const f32x4 ga0 = *(const f32x4*)(u.gqr + i0), ga1 = *(const f32x4*)(u.gqr + i0 + 4), gb0 = *(const f32x4*)(u.gqr + 32 + i0), gb1 = *(const f32x4*)(u.gqr + 32 + i0 + 4);
            float y1[8], y2[8];
#pragma unroll
            for (int e = 0; e < 8; ++e) { const float v1 = x1[e] * rr_ * (e < 4 ? ga0[e & 3] : ga1[e & 3]), v2 = x2[e] * rr_ * (e < 4 ? gb0[e & 3] : gb1[e & 3]);
                const float2 cs = u.tab[pos * 32 + i0 + e];
                y1[e] = (v1 * cs.x - v2 * cs.y) * QSCALE; y2[e] = (v2 * cs.x + v1 * cs.y) * QSCALE; }
            qr[8 + a] = __builtin_bit_cast(bf16x8, pack8(y1)); qr[10 + a] = __builtin_bit_cast(bf16x8, pack8(y2)); }
    }
    float m_reg = -1e30f, l_reg = 0.f; f32x16 o[4]; o[0] = f32x16{}; o[1] = f32x16{}; o[2] = f32x16{}; o[3] = f32x16{};
    LAS float* wsf = (LAS float*)(lds + OFF_WS) + wid * 64; LAS float* li_l = wsf; LAS float* al_l = wsf + 32;
    const int vb0 = (int)(unsigned)(uintptr_t)lds + v_rd_base(lane);
    AWAITV();
    __syncthreads();
#define ASTEP(BF, j) do { const int j_ = (j); const bool more_ = (VAR != 2) && (j_ + 1 < u.nt); \
        if (more_) ADMA(j_ + 1, (BF) ^ 1); \
        if (wact && j_ <= jmax) { \
            f32x16 p0, p1; if (VAR == 3) { _Pragma("unroll") for (int r = 0; r < 16; ++r) { p0[r] = (float)(r + j_) * 0.01f; p1[r] = (float)(r32 + r) * 0.01f; } } else qkt<BF>(p0, p1, lds, r32, hi, qr); \
            if (u.lastmask && j_ == u.nt - 1) { _Pragma("unroll") for (int r = 0; r < 16; ++r) p1[r] = -__builtin_inff(); } \
            if (VAR != 1) { \
            float pmax = p0[0]; _Pragma("unroll") for (int r = 1; r < 16; ++r) pmax = fmaxf(pmax, p0[r]); _Pragma("unroll") for (int r = 0; r < 16; ++r) pmax = fmaxf(pmax, p1[r]); \
            { auto rr = __builtin_amdgcn_permlane32_swap(__float_as_uint(pmax), __float_as_uint(pmax), false, false); pmax = fmaxf(__uint_as_float(rr[0]), __uint_as_float(rr[1])); } \
            const float mx_ = fmaxf(m_reg, pmax); const float mn = (mx_ - m_reg > 8.f) ? mx_ : m_reg;     \
            const float alpha = __builtin_amdgcn_exp2f(m_reg - mn); m_reg = mn; \
            _Pragma("unroll") for (int r = 0; r < 16; ++r) { p0[r] = __builtin_amdgcn_exp2f(p0[r] - mn); p1[r] = __builtin_amdgcn_exp2f(p1[r] - mn); } \
            float ps = 0.f; _Pragma("unroll") for (int r = 0; r < 16; ++r) ps += p0[r]; _Pragma("unroll") for (int r = 0; r < 16; ++r) ps += p1[r]; \
            { auto rr = __builtin_amdgcn_permlane32_swap(__float_as_uint(ps), __float_as_uint(ps), false, false); ps = __uint_as_float(rr[0]) + __uint_as_float(rr[1]); } \
            l_reg = l_reg * alpha + ps; \
            if (__any(alpha < 1.f)) { if (hi == 0) al_l[r32] = alpha; asm volatile("s_waitcnt lgkmcnt(0)" ::: "memory"); \
                _Pragma("unroll") for (int d_ = 0; d_ < 4; ++d_) _Pragma("unroll") for (int r = 0; r < 16; ++r) o[d_][r] *= al_l[crow(r, hi)]; } \
            } \
            bf16x8 pa0, pa1, pa2, pa3; \
            APK4(p0, 0, pa0); APK4(p0, 8, pa1); APK4(p1, 0, pa2); APK4(p1, 8, pa3); \
            SBAR(); pv_tile<BF>(o, vb0, pa0, pa1, pa2, pa3); } \
        if (more_) { AWAITV(); } \
        __syncthreads(); } while (0)
#define APK4(P, B_, OUT) do { unsigned a0 = cvtpk(P[B_+0], P[B_+1]), a1 = cvtpk(P[B_+2], P[B_+3]); \
        unsigned b0 = cvtpk(P[B_+4], P[B_+5]), b1 = cvtpk(P[B_+6], P[B_+7]); \
        auto r0 = __builtin_amdgcn_permlane32_swap(a0, b0, false, false); auto r1 = __builtin_amdgcn_permlane32_swap(a1, b1, false, false); \
        u32x4 w = {r0[0], r1[0], r0[1], r1[1]}; OUT = __builtin_bit_cast(bf16x8, w); } while (0)
    for (int j = 0; j < u.nt; j += 2) {
        ASTEP(0, j);
        if (j + 1 < u.nt) ASTEP(1, j + 1);
    }
    if (wact) {
        if (hi == 0) li_l[r32] = l_reg;
        asm volatile("s_waitcnt lgkmcnt(0)" ::: "memory");
        float rli[16];
#pragma unroll
        for (int r = 0; r < 16; ++r) rli[r] = __builtin_amdgcn_rcpf(li_l[crow(r, hi)]);
        bf16_t* Ow = u.O + (size_t)(wid * 32) * DM;
        const bool ev = (r32 & 1) == 0;
        unsigned gg[16][4];
        if (ev) {
#pragma unroll
            for (int r = 0; r < 16; ++r)
#pragma unroll
                for (int d0 = 0; d0 < 4; ++d0) gg[r][d0] = *(const unsigned*)(Ow + (size_t)crow(r, hi) * DM + d0 * 32 + r32);
        }
#pragma unroll
        for (int r = 0; r < 16; ++r) { const int orow = crow(r, hi);
#pragma unroll
            for (int d0 = 0; d0 < 4; ++d0) { const float v = o[d0][r] * rli[r]; const float vn = __shfl_xor(v, 1);
                if (ev) { unsigned* p = (unsigned*)(Ow + (size_t)orow * DM + d0 * 32 + r32); const unsigned g = gg[r][d0]; *p = cvtpk(v * bflo(g), vn * bfhi(g)); } } }
    }
#undef ADMA
#undef AWAITV
#undef ASTEP
#undef APK4
}
#undef SBAR
}


namespace chk {
constexpr int CHKB = 15360;
constexpr int O_GA = 0, O_RA = 8192, O_HA = 10240, O_MA = 12288, O_VB = 12800, O_P = 14848;
typedef __bf16 cbf16x2 __attribute__((ext_vector_type(2)));
__device__ __forceinline__ unsigned cpk(float lo, float hi) { const f32x2 v = {lo, hi}; const cbf16x2 b = __builtin_convertvector(v, cbf16x2); return __builtin_bit_cast(unsigned, b); }
__device__ __forceinline__ bf16_t cbf(float f) { return (bf16_t)(cpk(f, 0.f) & 0xffffu); }
__device__ __forceinline__ u32x4 cpack8(const float* f) { u32x4 w; w.x = cpk(f[0], f[1]); w.y = cpk(f[2], f[3]); w.z = cpk(f[4], f[5]); w.w = cpk(f[6], f[7]); return w; }
__device__ __forceinline__ s16x4 pack4(const f32x4& a) { u32x2 w; w.x = cpk(a.x, a.y); w.y = cpk(a.z, a.w); return __builtin_bit_cast(s16x4, w); }
__device__ __forceinline__ bf16x8 pack8(const f32x4& a, const f32x4& b) { u32x4 w; w.x = cpk(a.x, a.y); w.y = cpk(a.z, a.w); w.z = cpk(b.x, b.y); w.w = cpk(b.z, b.w); return __builtin_bit_cast(bf16x8, w); }
__device__ __forceinline__ f32x4 mm32(bf16x8 a, bf16x8 b, f32x4 c) { f32x4 d = __builtin_amdgcn_mfma_f32_16x16x32_bf16(a, b, c, 0, 0, 0); asm volatile("" : "+v"(d) : "v"(a), "v"(b)); return d; }
__device__ __forceinline__ f32x4 mm16(s16x4 a, s16x4 b, f32x4 c) { f32x4 d = __builtin_amdgcn_mfma_f32_16x16x16bf16_1k(a, b, c, 0, 0, 0); asm volatile("" : "+v"(d) : "v"(a), "v"(b)); return d; }
#define CHK_LW() asm volatile("s_waitcnt lgkmcnt(0)" ::: "memory")

struct Raw { float w[16], kk[16], b[16], r[16], k[16], v[16]; };
__device__ __forceinline__ void raw_load(Raw& x, const char* rec, int lane) {
    const int fr = lane & 15, fq = lane >> 4;
#pragma unroll
    for (int t = 0; t < 16; ++t) {
        const float* rp = (const float*)(rec + (size_t)t * REC) + lane; const bf16_t* hp = (const bf16_t*)(rec + (size_t)t * REC + 768) + lane;
        x.w[t] = rp[0]; x.kk[t] = rp[64]; x.b[t] = rp[128]; x.r[t] = bf2f(hp[0]); x.k[t] = bf2f(hp[64]);
    }
#pragma unroll
    for (int vt = 0; vt < 4; ++vt)
#pragma unroll
        for (int e = 0; e < 4; ++e) x.v[vt * 4 + e] = bf2f(*(const bf16_t*)(rec + (size_t)(4 * fq + e) * REC + 1024 + (16 * vt + fr) * 2));
}
__device__ __forceinline__ void precompute(const char* rec, char* out, LAS char* wl, int lane) {
    const int fr = lane & 15, fq = lane >> 4;
    Raw x; raw_load(x, rec, lane);
    const f32x4 zero4 = (f32x4){0.f, 0.f, 0.f, 0.f};
    float At[16], Rt[16], Bt[16], Kt[16];
    float P = 1.f;
#pragma unroll
    for (int t = 0; t < 16; ++t) {
        const float Pm1 = P; P *= x.w[t]; const float ip = __builtin_amdgcn_rcpf(P);
        At[t] = -x.kk[t] * Pm1; Rt[t] = x.r[t] * P; Bt[t] = x.b[t] * ip; Kt[t] = x.k[t] * ip;
    }
    const float P15 = P;
#pragma unroll
    for (int vt = 0; vt < 4; ++vt) *(s16x4*)(out + O_VB + vt * 512 + lane * 8) = pack4((f32x4){x.v[vt * 4 + 0], x.v[vt * 4 + 1], x.v[vt * 4 + 2], x.v[vt * 4 + 3]});
    *(float*)(out + O_P + lane * 4) = P15;
    {
        LAS bf16_t* X = (LAS bf16_t*)wl;
#pragma unroll
        for (int t = 0; t < 16; ++t) {
            const int idx = t * 64 + ((((lane >> 3) ^ ((t >> 1) & 7))) << 3) + (lane & 7);
            const bf16_t bh = cbf(Bt[t]), ah = cbf(At[t]);
            X[idx] = bh; X[1024 + idx] = cbf(Bt[t] - bf2f(bh)); X[2048 + idx] = ah; X[3072 + idx] = cbf(At[t] - bf2f(ah)); X[4096 + idx] = cbf(Kt[t]); X[5120 + idx] = cbf(Rt[t]);
        }
        float bc[16];
#pragma unroll
        for (int t = 0; t < 16; ++t) bc[t] = Bt[t] * P15;
        LAS u32x4* at_t = (LAS u32x4*)(wl + 12288 + lane * 32); LAS u32x4* bc_t = (LAS u32x4*)(wl + 14336 + lane * 32);
        at_t[0] = cpack8(At); at_t[1] = cpack8(At + 8); bc_t[0] = cpack8(bc); bc_t[1] = cpack8(bc + 8);
    }
    CHK_LW();
    f32x4 Nc = zero4, Makc = zero4, Mrbc = zero4, Mrkc = zero4;
    {
#pragma unroll
        for (int s2 = 0; s2 < 2; ++s2) {
            const int off = fr * 128 + (((fq + 4 * s2) ^ ((fr >> 1) & 7)) << 4);
            const bf16x8 bh = *(LAS const bf16x8*)(wl + off), bl = *(LAS const bf16x8*)(wl + 2048 + off), ah = *(LAS const bf16x8*)(wl + 4096 + off), al = *(LAS const bf16x8*)(wl + 6144 + off);
            const bf16x8 kh = *(LAS const bf16x8*)(wl + 8192 + off), rh = *(LAS const bf16x8*)(wl + 10240 + off);
            Nc = mm32(bh, ah, Nc); Nc = mm32(bh, al, Nc); Nc = mm32(bl, ah, Nc);
            Makc = mm32(kh, ah, Makc); Mrbc = mm32(bh, rh, Mrbc); Mrkc = mm32(kh, rh, Mrkc);
        }
#pragma unroll
        for (int j = 0; j < 4; ++j) { const int i = 4 * fq + j; if (!(i < fr)) { Nc[j] = 0.f; Makc[j] = 0.f; } if (!(i <= fr)) { Mrbc[j] = 0.f; Mrkc[j] = 0.f; } }
    }
    CHK_LW();
    {
        LAS float* NS = (LAS float*)wl; LAS bf16_t* MAK = (LAS bf16_t*)(wl + 1536);
#pragma unroll
        for (int j = 0; j < 4; ++j) { NS[(4 * fq + j) * 16 + fr] = Nc[j]; MAK[(4 * fq + j) * 16 + fr] = cbf(Makc[j]); }
        CHK_LW();
        float T[16];
#pragma unroll
        for (int i = 15; i >= 0; --i) {
            float acc = 0.f;
#pragma unroll
            for (int q4 = (i + 1) / 4; q4 < 4; ++q4) { const f32x4 nv = *(LAS const f32x4*)(NS + i * 16 + q4 * 4);
#pragma unroll
                for (int e = 0; e < 4; ++e) { const int jj = q4 * 4 + e; if (jj > i) acc += nv[e] * T[jj]; } }
            T[i] = (i == fr) ? 1.f : ((i < fr) ? acc : 0.f);
        }
        LAS u32x4* tt = (LAS u32x4*)(wl + 1024 + fr * 32);
        tt[0] = cpack8(T); tt[1] = cpack8(T + 8);
    }
    CHK_LW();
#define CHK_A16(base, rowb) (*(LAS const s16x4*)(wl + (base) + ((rowb) + fr) * 32 + fq * 8))
    const s16x4 TTf = CHK_A16(1024, 0);
    {
        LAS bf16_t* AH = (LAS bf16_t*)(wl + 2560); LAS bf16_t* MAKP = (LAS bf16_t*)(wl + 2048);
        f32x4 ahc[4];
#pragma unroll
        for (int mk = 0; mk < 4; ++mk) ahc[mk] = mm16(CHK_A16(12288, 16 * mk), TTf, zero4);
        const f32x4 makp = mm16(CHK_A16(1536, 0), TTf, zero4);
#pragma unroll
        for (int mk = 0; mk < 4; ++mk)
#pragma unroll
            for (int j = 0; j < 4; ++j) AH[(16 * mk + 4 * fq + j) * 16 + fr] = cbf(ahc[mk][j]);
#pragma unroll
        for (int j = 0; j < 4; ++j) MAKP[(4 * fq + j) * 16 + fr] = cbf(makp[j]);
        float kc[16];
#pragma unroll
        for (int t = 0; t < 16; ++t) kc[t] = Kt[t] * P15;
        LAS u32x4* rt_t = (LAS u32x4*)(wl + 4608 + lane * 32); LAS u32x4* kc_t = (LAS u32x4*)(wl + 6656 + lane * 32);
        rt_t[0] = cpack8(Rt); rt_t[1] = cpack8(Rt + 8); kc_t[0] = cpack8(kc); kc_t[1] = cpack8(kc + 8);
    }
    CHK_LW();
    const s16x4 Mrb_b = pack4(Mrbc);
    s16x4 Ident;
#pragma unroll
    for (int e = 0; e < 4; ++e) Ident[e] = (4 * fq + e == fr) ? (short)0x3F80 : (short)0;
    {
        f32x4 rh[4];
#pragma unroll
        for (int mk = 0; mk < 4; ++mk) { f32x4 d = mm16(CHK_A16(2560, 16 * mk), Mrb_b, zero4); rh[mk] = mm16(CHK_A16(4608, 16 * mk), Ident, d); }
        *(bf16x8*)(out + O_RA + lane * 16) = pack8(rh[0], rh[1]);
        *(bf16x8*)(out + O_RA + 1024 + lane * 16) = pack8(rh[2], rh[3]);
    }
    { const f32x4 mo = mm16(CHK_A16(2048, 0), Mrb_b, Mrkc); *(s16x4*)(out + O_MA + lane * 8) = pack4(mo); }
#pragma unroll
    for (int nk = 0; nk < 4; ++nk) {
        const s16x4 bcf = CHK_A16(14336, 16 * nk);
        f32x4 gc[4];
#pragma unroll
        for (int mk = 0; mk < 4; ++mk) gc[mk] = mm16(CHK_A16(2560, 16 * mk), bcf, zero4);
        *(bf16x8*)(out + O_GA + (nk * 2 + 0) * 1024 + lane * 16) = pack8(gc[0], gc[1]);
        *(bf16x8*)(out + O_GA + (nk * 2 + 1) * 1024 + lane * 16) = pack8(gc[2], gc[3]);
        f32x4 hc = mm16(CHK_A16(2048, 0), bcf, zero4); hc = mm16(Ident, CHK_A16(6656, 16 * nk), hc);
        *(s16x4*)(out + O_HA + nk * 512 + lane * 8) = pack4(hc);
    }
    CHK_LW();
#undef CHK_A16
}

struct Ops { bf16x8 ga[4][2]; bf16x8 ra[2]; s16x4 ha[4]; s16x4 ma, vb; f32x4 p[4]; };
__device__ __forceinline__ void load_ops(Ops& o, const char* c, int vt, int lane) {
    const int fq = lane >> 4;
#pragma unroll
    for (int mt = 0; mt < 4; ++mt) {
#pragma unroll
        for (int s2 = 0; s2 < 2; ++s2) o.ga[mt][s2] = *(const bf16x8*)(c + O_GA + (mt * 2 + s2) * 1024 + lane * 16);
        o.ha[mt] = *(const s16x4*)(c + O_HA + mt * 512 + lane * 8);
        o.p[mt] = *(const f32x4*)(c + O_P + (16 * mt + 4 * fq) * 4);
    }
    o.ra[0] = *(const bf16x8*)(c + O_RA + lane * 16); o.ra[1] = *(const bf16x8*)(c + O_RA + 1024 + lane * 16);
    o.ma = *(const s16x4*)(c + O_MA + lane * 8); o.vb = *(const s16x4*)(c + O_VB + vt * 512 + lane * 8);
}
__device__ __forceinline__ void step(f32x4 (&Z)[4], const Ops& o, float* orow  , int fq) {
    const bf16x8 bz0 = pack8(Z[0], Z[1]), bz1 = pack8(Z[2], Z[3]);
    f32x4 ot = mm32(o.ra[0], bz0, (f32x4){0.f, 0.f, 0.f, 0.f});
    f32x4 zn[4];
#pragma unroll
    for (int mt = 0; mt < 4; ++mt) zn[mt] = mm32(o.ga[mt][0], bz0, o.p[mt] * Z[mt]);
    ot = mm32(o.ra[1], bz1, ot);
#pragma unroll
    for (int mt = 0; mt < 4; ++mt) zn[mt] = mm32(o.ga[mt][1], bz1, zn[mt]);
    ot = mm16(o.ma, o.vb, ot);
#pragma unroll
    for (int mt = 0; mt < 4; ++mt) Z[mt] = mm16(o.ha[mt], o.vb, zn[mt]);
#pragma unroll
    for (int j = 0; j < 4; ++j) orow[(size_t)(4 * fq + j) * RW] = ot[j];
    asm volatile("" :: "v"(o.ga[0][0]), "v"(o.ga[0][1]), "v"(o.ga[1][0]), "v"(o.ga[1][1]), "v"(o.ga[2][0]), "v"(o.ga[2][1]), "v"(o.ga[3][0]), "v"(o.ga[3][1]),
                 "v"(o.ra[0]), "v"(o.ra[1]), "v"(o.ha[0]), "v"(o.ha[1]), "v"(o.ha[2]), "v"(o.ha[3]), "v"(o.ma), "v"(o.vb), "v"(bz0), "v"(bz1));
}
constexpr int RING_SLOTS = 7, SLOT_B = 16384, AHEAD = 6;
__device__ __forceinline__ void lds_ops(Ops& o, LAS const char* c, int vt, int lane) {
    const int fq = lane >> 4;
#pragma unroll
    for (int mt = 0; mt < 4; ++mt) {
#pragma unroll
        for (int s2 = 0; s2 < 2; ++s2) o.ga[mt][s2] = *(LAS const bf16x8*)(c + O_GA + (mt * 2 + s2) * 1024 + lane * 16);
        o.ha[mt] = *(LAS const s16x4*)(c + O_HA + mt * 512 + lane * 8);
        o.p[mt] = *(LAS const f32x4*)(c + O_P + (16 * mt + 4 * fq) * 4);
    }
    o.ra[0] = *(LAS const bf16x8*)(c + O_RA + lane * 16); o.ra[1] = *(LAS const bf16x8*)(c + O_RA + 1024 + lane * 16);
    o.ma = *(LAS const s16x4*)(c + O_MA + lane * 8); o.vb = *(LAS const s16x4*)(c + O_VB + vt * 512 + lane * 8);
}
__device__ __forceinline__ void seq_wg(const char* c0, int nch, const float* S0, float* o_out, float* s_out, LAS char* lds, int wave, int lane) {
    const int fr = lane & 15, fq = lane >> 4;
#define RAWBAR() do { asm volatile("" ::: "memory"); __builtin_amdgcn_s_barrier(); asm volatile("" ::: "memory"); } while (0)
    if (wave >= 4) {
        const int pw = (wave - 4) * 4;
        const char* src0 = c0 + (size_t)pw * 1024 + lane * 16;
#define FEED(ci, slot) do { const int ci_ = (ci) < nch ? (ci) : nch - 1; const char* s_ = src0 + (size_t)ci_ * CHKB; LAS char* d_ = lds + (slot) * SLOT_B + pw * 1024; \
            _Pragma("unroll") for (int q = 0; q < 4; ++q) __builtin_amdgcn_global_load_lds((const unsigned*)(s_ + q * 1024), (LAS unsigned*)(d_ + q * 1024), 16, 0, 0); } while (0)
#pragma unroll
        for (int i = 0; i < AHEAD; ++i) FEED(i, i);
        asm volatile("s_waitcnt vmcnt(20)" ::: "memory");
        RAWBAR();
        int slot = AHEAD;
        for (int c = 0; c < nch; ++c) {
            FEED(c + AHEAD, slot); slot = (slot == RING_SLOTS - 1) ? 0 : slot + 1;
            asm volatile("s_waitcnt vmcnt(20)" ::: "memory");
            RAWBAR();
        }
        asm volatile("s_waitcnt vmcnt(0)" ::: "memory");
        RAWBAR();
#undef FEED
    } else {
        const int vt = wave;
        f32x4 Z[4];
#pragma unroll
        for (int mt = 0; mt < 4; ++mt) Z[mt] = S0 ? *(const f32x4*)(S0 + (16 * vt + fr) * 64 + 16 * mt + 4 * fq) : (f32x4){0.f, 0.f, 0.f, 0.f};
        float* ocol = o_out + 16 * vt + fr;
        Ops A, B;
        RAWBAR();
        lds_ops(A, lds, vt, lane);
        int slot = 1;
#pragma unroll 1
        for (int c = 0; c < nch; c += 2) {
            asm volatile("s_waitcnt lgkmcnt(0)" ::: "memory");
            RAWBAR();
            lds_ops(B, lds + slot * SLOT_B, vt, lane); slot = (slot == RING_SLOTS - 1) ? 0 : slot + 1;
            step(Z, A, ocol + (size_t)(16 * c) * RW, fq);
            asm volatile("s_waitcnt lgkmcnt(0)" ::: "memory");
            RAWBAR();
            lds_ops(A, lds + slot * SLOT_B, vt, lane); slot = (slot == RING_SLOTS - 1) ? 0 : slot + 1;
            step(Z, B, ocol + (size_t)(16 * (c + 1)) * RW, fq);
        }
#pragma unroll
        for (int mt = 0; mt < 4; ++mt) *(f32x4*)(s_out + (16 * vt + fr) * 64 + 16 * mt + 4 * fq) = Z[mt];
        asm volatile("s_waitcnt lgkmcnt(0)" : "+v"(A.ga[0][0]), "+v"(A.ra[0]) :: "memory");
        RAWBAR();
    }
#undef RAWBAR
}
#undef CHK_LW
}

constexpr int RING_BYTES = 131072;
constexpr int LDSCTL_OFF = RING_BYTES, MISC_OFF = LDSCTL_OFF + 320, XL_OFF = LDSCTL_OFF + 1024;
constexpr int LDS_BYTES = 147456;
static_assert(att::LDS_BYTES <= RING_BYTES && pg8::STAGE_BYTES <= RING_BYTES && XL_OFF + 8192 <= LDS_BYTES, "LDS map");
constexpr int NWAVES = 8, NPHASE = 16;

struct Args { const float* in[35]; float* out; unsigned char* ws; int ph_lo, ph_hi, li, pad; };

__device__ __forceinline__ void transpose_item(const float* W, int K, int N, bf16_t* WT, int row_off, LAS float* scr, int item, int lane) {
    const int nblk = N / 32, kb = item / nblk, nb = item % nblk, k0 = 64 * kb, n0 = 32 * nb;
    float tv[32];
    const float* wsrc = W + (size_t)(k0 + (lane >> 5)) * N + n0 + (lane & 31);
#pragma unroll
    for (int i = 0; i < 32; ++i) tv[i] = wsrc[(size_t)(2 * i) * N];
#pragma unroll
    for (int i = 0; i < 32; ++i) scr[(2 * i + (lane >> 5)) * 33 + (lane & 31)] = tv[i];
    asm volatile("s_waitcnt lgkmcnt(0)" ::: "memory");
    const int c = lane & 7;
#pragma unroll
    for (int j = 0; j < 4; ++j) { const int n = (lane >> 3) + 8 * j; const LAS float* s = scr + (8 * c) * 33 + n;
        u32x4 o; o.x = cvtpk(s[0 * 33], s[1 * 33]); o.y = cvtpk(s[2 * 33], s[3 * 33]); o.z = cvtpk(s[4 * 33], s[5 * 33]); o.w = cvtpk(s[6 * 33], s[7 * 33]);
        *(u32x4*)(WT + (size_t)(row_off + n0 + n) * K + k0 + 8 * c) = o; }
    asm volatile("s_waitcnt lgkmcnt(0)" ::: "memory");
}
__device__ __forceinline__ void convert_weights(const Args& a, int l, LAS unsigned char* lds, int gw, int ngw, int wave, int lane, int which, unsigned* ticket) {
    unsigned char* ws = a.ws;
    bf16_t* wtin = (bf16_t*)(ws + WS_WTIN); bf16_t* wtout = (bf16_t*)(ws + WS_WTOUT); bf16_t* wtuq = (bf16_t*)(ws + WS_WTUQ); bf16_t* wtukv = (bf16_t*)(ws + WS_WTUKV);
    const float* w_in = a.in[12] + (size_t)l * DM * IN_COLS; const float* w_out = a.in[34] + (size_t)l * DM * DM;
    const float* w_uq = a.in[25] + (size_t)l * QL * QW; const float* w_uk = a.in[26] + (size_t)l * KVL * MLAD; const float* w_uv = a.in[27] + (size_t)l * KVL * MLAD;
    LAS float* scr = (LAS float*)(lds + wave * 16384);
    constexpr int I_IN = (DM / 64) * (IN_COLS / 32), I_OUT = (DM / 64) * (DM / 32), I_UQ = (QL / 64) * (QW / 32), I_UK = (KVL / 64) * (MLAD / 32);
    const int n_in = (which & 1) ? I_IN : 0, n_out = (which & 2) ? I_OUT : 0, n_uq = (which & 4) ? I_UQ : 0, n_uk = (which & 4) ? I_UK : 0;
    const int NITEMS = n_in + n_out + n_uq + 2 * n_uk;
    if (!ticket) {
#define CW_DECODE(it_, W_, K_, N_, WT_, off_, r_) do { int r0_ = (it_); W_ = w_in; K_ = DM; N_ = IN_COLS; WT_ = wtin; off_ = 0; \
            if (r0_ >= n_in) { r0_ -= n_in; W_ = w_out; K_ = DM; N_ = DM; WT_ = wtout; \
                if (r0_ >= n_out) { r0_ -= n_out; W_ = w_uq; K_ = QL; N_ = QW; WT_ = wtuq; \
                    if (r0_ >= n_uq) { r0_ -= n_uq; W_ = w_uk; K_ = KVL; N_ = MLAD; WT_ = wtukv; \
                        if (r0_ >= n_uk) { r0_ -= n_uk; W_ = w_uv; off_ = MLAD; } } } } r_ = r0_; } while (0)
#define CW_LOAD(tv_, W_, N_, r_) do { const int nblk_ = (N_) / 32, k0_ = 64 * ((r_) / nblk_), n0_ = 32 * ((r_) % nblk_); \
            const float* wsrc_ = (W_) + (size_t)(k0_ + (lane >> 5)) * (N_) + n0_ + (lane & 31); \
            _Pragma("unroll") for (int i = 0; i < 32; ++i) tv_[i] = wsrc_[(size_t)(2 * i) * (N_)]; } while (0)
        if (gw < NITEMS) {
            const float* Wc; bf16_t* WTc; int Kc, Nc, offc, rc;
            float tv[32];
            CW_DECODE(gw, Wc, Kc, Nc, WTc, offc, rc); CW_LOAD(tv, Wc, Nc, rc);
#pragma unroll 1
            for (int it = gw; it < NITEMS; it += ngw) {
                const int itn = it + ngw < NITEMS ? it + ngw : NITEMS - 1;
                const float* Wn; bf16_t* WTn; int Kn_, Nn, offn, rn;
                float tn[32];
                CW_DECODE(itn, Wn, Kn_, Nn, WTn, offn, rn); CW_LOAD(tn, Wn, Nn, rn);
                {
                    const int nblk = Nc / 32, k0 = 64 * (rc / nblk), n0 = 32 * (rc % nblk);
#pragma unroll
                    for (int i = 0; i < 32; ++i) scr[(2 * i + (lane >> 5)) * 33 + (lane & 31)] = tv[i];
                    asm volatile("s_waitcnt lgkmcnt(0)" ::: "memory");
                    const int c = lane & 7;
#pragma unroll
                    for (int j = 0; j < 4; ++j) { const int n = (lane >> 3) + 8 * j; const LAS float* sp = scr + (8 * c) * 33 + n;
                        u32x4 o; o.x = cvtpk(sp[0 * 33], sp[1 * 33]); o.y = cvtpk(sp[2 * 33], sp[3 * 33]); o.z = cvtpk(sp[4 * 33], sp[5 * 33]); o.w = cvtpk(sp[6 * 33], sp[7 * 33]);
                        *(u32x4*)(WTc + (size_t)(offc + n0 + n) * Kc + k0 + 8 * c) = o; }
                    asm volatile("s_waitcnt lgkmcnt(0)" ::: "memory");
                }
#pragma unroll
                for (int i = 0; i < 32; ++i) tv[i] = tn[i];
                Wc = Wn; WTc = WTn; Kc = Kn_; Nc = Nn; offc = offn; rc = rn;
            }
        }
#undef CW_DECODE
#undef CW_LOAD
    } else {
    int it = gw, left = 0;
    for (;; ) {
        if (ticket) {
            if (left == 0) { unsigned tk = 0; if (lane == 0) tk = __hip_atomic_fetch_add(ticket, 8u, __ATOMIC_RELAXED, __HIP_MEMORY_SCOPE_AGENT); it = (int)__builtin_amdgcn_readfirstlane(tk); left = 8; }
            else ++it;
            --left;
        }
        if (it >= NITEMS) break;
        int r = it;
        if (!ticket) it += ngw;
        if (r < n_in) { transpose_item(w_in, DM, IN_COLS, wtin, 0, scr, r, lane); continue; } r -= n_in;
        if (r < n_out) { transpose_item(w_out, DM, DM, wtout, 0, scr, r, lane); continue; } r -= n_out;
        if (r < n_uq) { transpose_item(w_uq, QL, QW, wtuq, 0, scr, r, lane); continue; } r -= n_uq;
        if (r < n_uk) { transpose_item(w_uk, KVL, MLAD, wtukv, 0, scr, r, lane); continue; } r -= n_uk;
        transpose_item(w_uv, KVL, MLAD, wtukv, MLAD, scr, r, lane);
    }
    }
    if (which & 1) { unsigned zz; asm volatile("v_mov_b32 %0, 0" : "=v"(zz));
        for (int p = gw * 64 + lane; p < 64 * DM / 8; p += ngw * 64) *(u32x4*)(wtin + (size_t)IN_COLS * DM + (size_t)p * 8) = (u32x4){zz, zz, zz, zz}; }
}

#define PHASE_LOCALS \
    int t__ = threadIdx.x; asm volatile("" : "+v"(t__)); \
    unsigned long long z__ = 0; asm volatile("" : "+s"(z__)); \
    unsigned char* ws = args.ws + z__; float* out = args.out + z__; \
    int g__ = (int)gridDim.x, b__ = (int)blockIdx.x; asm volatile("" : "+s"(g__), "+s"(b__)); const int G = g__, bx = b__;     \
    const int tid = t__, lane = tid & 63, wave = __builtin_amdgcn_readfirstlane(tid >> 6); \
    const int gw = bx * NWAVES + wave, ngw = G * NWAVES; \
    float2* tab = (float2*)(ws + WS_TAB); float* modp = (float*)(ws + WS_MODP); float* modf = (float*)(ws + WS_MODF); float* rkdot = (float*)(ws + WS_RKDOT); \
    bf16_t* wtin = (bf16_t*)(ws + WS_WTIN); bf16_t* wtout = (bf16_t*)(ws + WS_WTOUT); bf16_t* wtuq = (bf16_t*)(ws + WS_WTUQ); bf16_t* wtukv = (bf16_t*)(ws + WS_WTUKV); \
    bf16_t* hmix = (bf16_t*)(ws + WS_HMIX); bf16_t* proj = (bf16_t*)(ws + WS_PROJ); bf16_t* Kn = (bf16_t*)(ws + WS_KN); bf16_t* Vb = (bf16_t*)(ws + WS_V); \
    char* scanrec = (char*)(ws + WS_SCAN); bf16_t* Qb = (bf16_t*)(ws + WS_Q); bf16_t* latall = (bf16_t*)(ws + WS_LAT); bf16_t* Krb = (bf16_t*)(ws + WS_KR); \
    float* obuf = (float*)(ws + WS_OBUF); bf16_t* qin = (bf16_t*)(ws + WS_QIN); \
    const float* xp = l == 0 ? args.in[0] : out + O_YP; const float* xs = l == 0 ? args.in[1] : out + O_YS; \
    const float* modf_l = modf + (size_t)l * 20 * 3 * DM; \
    (void)tid; (void)lane; (void)wave; (void)gw; (void)ngw; (void)tab; (void)modp; (void)modf; (void)rkdot; (void)wtin; (void)wtout; (void)wtuq; (void)wtukv; (void)hmix; (void)proj; (void)Kn; (void)Vb; \
    (void)scanrec; (void)Qb; (void)latall; (void)Krb; (void)obuf; (void)qin; (void)xp; (void)xs; (void)modf_l;
__global__ void __launch_bounds__(NWAVES * 64, 2) mk_fwd(Args args) {
    extern __shared__ __attribute__((aligned(16))) unsigned char lds_raw[];
    LAS unsigned char* lds = (LAS unsigned char*)lds_raw;
    volatile LAS unsigned* MISC = (volatile LAS unsigned*)(lds + MISC_OFF);
    const int G = gridDim.x, bx = blockIdx.x;
    unsigned* ctl = (unsigned*)(args.ws + WS_CTL);
    for (int u = threadIdx.x; u < (LDS_BYTES - LDSCTL_OFF) / 4; u += NWAVES * 64) ((LAS unsigned*)(lds + LDSCTL_OFF))[u] = 0u;
    __syncthreads();
    XcdBarrier bar = xcd_barrier_post(ctl + CW_BAR + args.li * XCD_BAR_WORDS, MISC + 8);
    const int lo = args.ph_lo, hi = args.ph_hi;
#define IN(k) (lo <= (k) && (k) < hi)
#define SEAM(k) do { if (IN(k) && IN((k) + 1)) xcd_barrier(bar); } while (0)

    if (IN(0) && EN(0)) {
        const int l = 0; PHASE_LOCALS
        for (int i = bx * 512 + tid; i < 4096 * 32; i += G * 512) {
            const int pos = i >> 5, fi = i & 31;
            const float ang = (float)pos * ROPE_FREQ[fi];
            double rev = (double)ang * 0.15915494309189535; rev -= __builtin_rint(rev);
            const float fr = (float)rev;
            tab[i] = make_float2(__builtin_amdgcn_cosf(fr), __builtin_amdgcn_sinf(fr));
        }
        {
            LAS float* cs = (LAS float*)lds;
            for (int w0 = bx; w0 < 256; w0 += G) {
                const int p = w0 % 24, sl = w0 / 24, np = p < 16 ? 11 : 10;
                const int lm = p / 12, cg = p % 12, col = cg * 1024 + tid * 2;
                f32x2 acc[20];
#pragma unroll
                for (int r2 = 0; r2 < 20; ++r2) acc[r2] = (f32x2){0.f, 0.f};
                for (int ch = sl; ch < 32; ch += np) {
                    const int k0 = ch * 128;
                    __syncthreads();
                    for (int e = tid; e < 20 * 128; e += 512) { const int row = e >> 7, k = e & 127;
                        cs[e] = row < 4 ? args.in[2][(size_t)row * DM + k0 + k] : args.in[3][(size_t)(row - 4) * DM + k0 + k]; }
                    __syncthreads();
                    const float* wp = args.in[9] + ((size_t)lm * DM + k0) * (3 * DM) + col;
#pragma unroll 2
                    for (int k = 0; k < 128; k += 4) {
                        const f32x2 wa = *(const f32x2*)(wp + (size_t)(k + 0) * (3 * DM)), wb = *(const f32x2*)(wp + (size_t)(k + 1) * (3 * DM));
                        const f32x2 wc = *(const f32x2*)(wp + (size_t)(k + 2) * (3 * DM)), wd = *(const f32x2*)(wp + (size_t)(k + 3) * (3 * DM));
#pragma unroll
                        for (int r2 = 0; r2 < 20; ++r2) { const f32x4 cv = *(LAS const f32x4*)(cs + r2 * 128 + k);
                            acc[r2] = wa * cv.x + acc[r2]; acc[r2] = wb * cv.y + acc[r2]; acc[r2] = wc * cv.z + acc[r2]; acc[r2] = wd * cv.w + acc[r2]; }
                    }
                }
                float* mp = modp + ((size_t)(lm * 11 + sl) * 20) * (3 * DM) + col;
#pragma unroll
                for (int r2 = 0; r2 < 20; ++r2) *(f32x2*)(mp + (size_t)r2 * (3 * DM)) = acc[r2];
            }
            __syncthreads();
        }
        {
            unsigned* w2p = (unsigned*)(ws + WS_W2P);
            for (int i = bx * 512 + tid; i < 2 * 2 * 32 * RW; i += G * 512) {
                const int c = i & 1023, ip = (i >> 10) & 31, mat = (i >> 15) & 1, lw_ = i >> 16;
                const float* src = (mat ? args.in[17] : args.in[15]) + (size_t)lw_ * 64 * RW;
                w2p[i] = cvtpk(src[(size_t)(2 * ip) * RW + c], src[(size_t)(2 * ip + 1) * RW + c]);
            }
        }
        convert_weights(args, 0, lds, gw, ngw, wave, lane, 7, nullptr);
    }
    SEAM(0);
    if (IN(1) && EN(1)) {
        const int l = 0; PHASE_LOCALS
        for (int i = bx * 512 + tid; i < 2 * 20 * DM; i += G * 512) {
            const int lf = i / (20 * DM), r = i % (20 * DM), seq = r / DM, col = r % DM;
            float sh = args.in[10][(size_t)lf * 3 * DM + col], sc = args.in[10][(size_t)lf * 3 * DM + DM + col], gt = args.in[10][(size_t)lf * 3 * DM + 2 * DM + col];
            for (int which = 0; which < 3; ++which) {
                const int c3 = which * DM + col, p = lf * 12 + (c3 >> 10);
                const int np = p < 16 ? 11 : 10;
                float a = 0.f;
                for (int sl = 0; sl < np; ++sl) a += modp[((size_t)(lf * 11 + sl) * 20 + seq) * (3 * DM) + c3];
                if (which == 0) sh += a; else if (which == 1) sc += a; else gt += a; }
            float* mf = modf + ((size_t)(lf * 20 + seq) * 3) * DM;
            mf[col] = args.in[11][(size_t)lf * DM + col] * (1.f + sc); mf[DM + col] = sh; mf[2 * DM + col] = gt;
        }
    }
    SEAM(1);

    for (int l = 0; l < DEPTH; ++l) {
        const int pb = 2 + 7 * l;
        if (IN(pb + 0) && EN(2)) {
            const bool splitA = (G == 256);
#define NORM_ROW(m) do { \
                const float* xr = (m) < MP ? xp + (size_t)(m) * DM : xs + (size_t)((m) - MP) * DM; \
                const int seq = (m) < MP ? ((m) >> 12) : 4 + (((m) - MP) >> 5); \
                const f32x4* x4 = (const f32x4*)xr + lane; \
                f32x4 v[16]; float ss = 0.f; \
                _Pragma("unroll") for (int j = 0; j < 16; ++j) { v[j] = x4[64 * j]; ss += (v[j].x * v[j].x + v[j].y * v[j].y) + (v[j].z * v[j].z + v[j].w * v[j].w); } \
                const float rstd = rsqrtf(wave_sum(ss) * (1.f / DM) + NORM_EPS); \
                const f32x4* A4 = (const f32x4*)(modf_l + (size_t)(seq * 3 + 0) * DM) + lane; \
                const f32x4* B4 = (const f32x4*)(modf_l + (size_t)(seq * 3 + 1) * DM) + lane; \
                u32x2* o8 = (u32x2*)(hmix + (size_t)(m) * DM) + lane; \
                _Pragma("unroll") for (int j = 0; j < 16; ++j) { const f32x4 av = A4[64 * j], bv = B4[64 * j]; const f32x4 y = v[j] * rstd * av + bv; \
                    u32x2 w; w.x = cvtpk(y.x, y.y); w.y = cvtpk(y.z, y.w); o8[64 * j] = w; } } while (0)
            {
                PHASE_LOCALS
                if (splitA) { for (int m = MP + gw; m < M; m += ngw) NORM_ROW(m); }
            }
            if (splitA) xcd_barrier(bar);
            {
                PHASE_LOCALS
                if (splitA && bx < 94) {
                    pg8::Gemm g{hmix + (size_t)MP * DM, wtin, MS, NPAD, DM}; pg8::StaticOrder S; S.init(MS, NPAD, 94, bx);
                    pg8::EpiBf16 E{proj + (size_t)MP * NPAD, NPAD, 0, 0};
                    pg8::gemm_phase<pg8::EpiBf16, pg8::StaticOrder, true, true>(lds, g, S, E);
                } else {
                    const int nw0 = splitA ? (bx - 94) * NWAVES + wave : gw, nnw = splitA ? (G - 94) * NWAVES : ngw;
                    if (l > 0) convert_weights(args, l, lds, nw0, nnw, wave, lane, 2, nullptr);
                    for (int m = nw0; m < (splitA ? MP : M); m += nnw) NORM_ROW(m);
                }
            }
#undef NORM_ROW
        }
        SEAM(pb + 0);
        if (IN(pb + 1) && EN(3)) {
            PHASE_LOCALS
            const int MB = (G == 256) ? MP : M;
            pg8::Gemm g{hmix, wtin, MB, NPAD, DM}; pg8::StaticOrder S; S.init(MB, NPAD, G, bx);
            pg8::EpiBf16 E{proj, NPAD, 0, 0};
            pg8::gemm_phase<pg8::EpiBf16, pg8::StaticOrder, true, true>(lds, g, S, E);
        }
        SEAM(pb + 1);
        if (IN(pb + 2) && EN(4)) {
            PHASE_LOCALS
            {
                LAS unsigned* actP = (LAS unsigned*)lds;
                const unsigned* w2pl = (const unsigned*)(ws + WS_W2P) + (size_t)l * 2 * 32 * RW;
                const float* mu = args.in[13] + (size_t)l * SHIFT_DIM;
                const float* w0p = args.in[14] + (size_t)l * RW; const float* w2p = args.in[15] + (size_t)l * 64 * RW;
                const float* a0p = args.in[16] + (size_t)l * RW; const float* a2p = args.in[17] + (size_t)l * 64 * RW;
                const float* kkp = args.in[18] + (size_t)l * RW; const float* kap = args.in[19] + (size_t)l * RW; const float* rkp = args.in[20] + (size_t)l * RW;
                const int h = tid >> 5, kp = tid & 31, c0 = 2 * tid;
                const f32x2 mu_r = *(const f32x2*)(mu + c0), mu_k = *(const f32x2*)(mu + RW + c0), mu_v = *(const f32x2*)(mu + 2 * RW + c0);
                const f32x2 w0v = *(const f32x2*)(w0p + c0), a0v = *(const f32x2*)(a0p + c0), kkw = *(const f32x2*)(kkp + c0), kaw = *(const f32x2*)(kap + c0), rkw = *(const f32x2*)(rkp + c0);
                for (int tile = bx; tile < M / 16; tile += G) {
                    const int m0 = tile * 16;
                    const bool smp = m0 >= MP;
                    const int b = smp ? ((m0 - MP) >> 5) : (m0 >> 12), t0 = smp ? ((m0 - MP) & 31) : (m0 & 4095);
                    const bool first = t0 == 0;
                    const float* shst = args.in[7] + (size_t)(l * DB + b) * SHIFT_DIM;
                    const size_t rec0 = smp ? (size_t)SREC_S0 + (size_t)(b * 16 + h) * DS + t0 : (size_t)(b * 16 + h) * SEQ + t0;
                    __syncthreads();
#pragma unroll
                    for (int e = 0; e < 4; ++e) { const int idx = tid + 512 * e, tok = idx >> 7, i = idx & 127, col = 3072 + i, m = m0 + tok;
                        const float cur = bf2f(proj[(size_t)m * NPAD + col]);
                        float prev;
                        if (tok == 0 && first) prev = smp ? shst[col] : 0.f; else prev = bf2f(proj[(size_t)(m - 1) * NPAD + col]);
                        float xsv = cur + (prev - cur) * mu[col];
                        if (i < 64) { const float e2 = __expf(2.f * xsv); xsv = 1.f - 2.f * __builtin_amdgcn_rcpf(e2 + 1.f); }
                        const float xo = __shfl_xor(xsv, 1);
                        if (!(i & 1)) actP[(i >> 1) * 16 + tok] = cvtpk(xsv, xo); }
                    __syncthreads();
                    unsigned pur[17], puk[17], puv[17];
#pragma unroll
                    for (int tok = 0; tok < 17; ++tok) { if (tok == 0 && first) { pur[0] = puk[0] = puv[0] = 0u; continue; }
                        const bf16_t* pp = proj + (size_t)(m0 + tok - 1) * NPAD + c0; pur[tok] = *(const unsigned*)pp; puk[tok] = *(const unsigned*)(pp + RW); puv[tok] = *(const unsigned*)(pp + 2 * RW); }
                    float lw[16][2], la[16][2];
#pragma unroll
                    for (int t = 0; t < 16; ++t) { lw[t][0] = 0.f; lw[t][1] = 0.f; la[t][0] = 0.f; la[t][1] = 0.f; }
                    u32x2 wvn = *(const u32x2*)(w2pl + c0), avn = *(const u32x2*)(w2pl + (size_t)32 * RW + c0);
                    for (int ip = 0; ip < 32; ++ip) {
                        const u32x2 wv = wvn, av = avn;
                        { const int ipn = ip < 31 ? ip + 1 : 31; wvn = *(const u32x2*)(w2pl + (size_t)ipn * RW + c0); avn = *(const u32x2*)(w2pl + (size_t)(32 + ipn) * RW + c0); }
#pragma unroll
                        for (int tq = 0; tq < 4; ++tq) { const u32x4 x4 = *(LAS const u32x4*)(actP + ip * 16 + tq * 4), y4 = *(LAS const u32x4*)(actP + (32 + ip) * 16 + tq * 4);
#pragma unroll
                            for (int e = 0; e < 4; ++e) { lw[tq * 4 + e][0] = DOT2(x4[e], wv.x, lw[tq * 4 + e][0]); lw[tq * 4 + e][1] = DOT2(x4[e], wv.y, lw[tq * 4 + e][1]);
                                                          la[tq * 4 + e][0] = DOT2(y4[e], av.x, la[tq * 4 + e][0]); la[tq * 4 + e][1] = DOT2(y4[e], av.y, la[tq * 4 + e][1]); } }
                    }
                    float pr[2], pk[2], pv[2];
                    if (first) { if (smp) { pr[0] = shst[c0]; pr[1] = shst[c0 + 1]; pk[0] = shst[RW + c0]; pk[1] = shst[RW + c0 + 1]; pv[0] = shst[2 * RW + c0]; pv[1] = shst[2 * RW + c0 + 1]; }
                                 else { pr[0] = pr[1] = pk[0] = pk[1] = pv[0] = pv[1] = 0.f; } }
                    else { const unsigned ur = pur[0], uk = puk[0], uv = puv[0];
                           pr[0] = bflo(ur); pr[1] = bfhi(ur); pk[0] = bflo(uk); pk[1] = bfhi(uk); pv[0] = bflo(uv); pv[1] = bfhi(uv); }
#pragma unroll
                    for (int tok = 0; tok < 16; ++tok) {
                        const int m = m0 + tok;
                        const unsigned ur = pur[tok + 1], uk = puk[tok + 1], uv = puv[tok + 1];
                        const float cr[2] = {bflo(ur), bfhi(ur)}, ck[2] = {bflo(uk), bfhi(uk)}, cv[2] = {bflo(uv), bfhi(uv)};
                        float rr[2], kk[2], vv[2], dec[2], aa[2], kkn[2], km[2], bb[2];
                        rr[0] = cr[0] + (pr[0] - cr[0]) * mu_r.x; rr[1] = cr[1] + (pr[1] - cr[1]) * mu_r.y;
                        kk[0] = ck[0] + (pk[0] - ck[0]) * mu_k.x; kk[1] = ck[1] + (pk[1] - ck[1]) * mu_k.y;
                        vv[0] = cv[0] + (pv[0] - cv[0]) * mu_v.x; vv[1] = cv[1] + (pv[1] - cv[1]) * mu_v.y;
                        dec[0] = __expf(-0.6065306597126334f * sigmoidf_(w0v.x + lw[tok][0])); dec[1] = __expf(-0.6065306597126334f * sigmoidf_(w0v.y + lw[tok][1]));
                        aa[0] = sigmoidf_(a0v.x + la[tok][0]); aa[1] = sigmoidf_(a0v.y + la[tok][1]);
                        kkn[0] = kk[0] * kkw.x; kkn[1] = kk[1] * kkw.y;
                        const float ssq = sum32(kkn[0] * kkn[0] + kkn[1] * kkn[1]);
                        const float inv = rsqrtf(ssq + 1e-12f);
                        kkn[0] *= inv; kkn[1] *= inv;
                        km[0] = kk[0] * (1.f + (aa[0] - 1.f) * kaw.x); km[1] = kk[1] * (1.f + (aa[1] - 1.f) * kaw.y);
                        bb[0] = kkn[0] * aa[0]; bb[1] = kkn[1] * aa[1];
                        const float rkd = sum32(rr[0] * km[0] * rkw.x + rr[1] * km[1] * rkw.y);
                        if (kp == 0) rkdot[(size_t)m * 16 + h] = rkd;
                        char* rec = scanrec + (rec0 + tok) * REC;
                        *(f32x2*)(rec + kp * 8) = (f32x2){dec[0], dec[1]};
                        *(f32x2*)(rec + 256 + kp * 8) = (f32x2){kkn[0], kkn[1]};
                        *(f32x2*)(rec + 512 + kp * 8) = (f32x2){bb[0], bb[1]};
                        *(unsigned*)(rec + 768 + kp * 4) = cvtpk(rr[0], rr[1]);
                        *(unsigned*)(rec + 896 + kp * 4) = cvtpk(km[0], km[1]);
                        *(unsigned*)(rec + 1024 + kp * 4) = cvtpk(vv[0], vv[1]);
                        pr[0] = cr[0]; pr[1] = cr[1]; pk[0] = ck[0]; pk[1] = ck[1]; pv[0] = cv[0]; pv[1] = cv[1];
                    }
                }
                __syncthreads();
            }
            {
                const float* gq = args.in[23] + (size_t)l * QL; const float* gkv = args.in[24] + (size_t)l * KVL; const float* gkr = args.in[31] + (size_t)l * ROPE;
                const float* cw = args.in[32] + (size_t)l * 3 * CONVD; const float* cb = args.in[33] + (size_t)l * CONVD;
                for (int m = gw; m < M; m += ngw) {
                    const bool smp = m >= MP;
                    const int b = smp ? ((m - MP) >> 5) : (m >> 12), t = smp ? ((m - MP) & 31) : (m & 4095);
                    const int pos = smp ? PAST + t : t;
                    const int T = smp ? DS : SEQ;
                    const size_t lrow = smp ? (size_t)MP + (size_t)b * SKEYS + PAST + t : (size_t)m;
                    float* lat_out = smp ? out + O_LATS + ((size_t)(l * DB + b) * DS + t) * KVL : out + O_LATP + ((size_t)(l * NB + b) * SEQ + t) * KVL;
                    float* kr_out = smp ? out + O_KRS + ((size_t)(l * DB + b) * DS + t) * ROPE : out + O_KRP + ((size_t)(l * NB + b) * SEQ + t) * ROPE;
                    const bf16_t* prow = proj + (size_t)m * NPAD;
                    const u32x4 rq0 = *(const u32x4*)(prow + C_CQ + lane * 8), rq1 = *(const u32x4*)(prow + C_CQ + 512 + lane * 8), rkv = *(const u32x4*)(prow + C_CKV + lane * 8);
                    const bf16_t rkr = prow[C_KR + lane];
                    u32x4 rgt[6];
#pragma unroll
                    for (int j = 0; j < 6; ++j) { const int c = j * 512 + lane * 8; rgt[j] = *(const u32x4*)(prow + (c < RW ? C_RWGATE + c : C_MGATE + (c - RW))); }
                    const bf16_t* prow1 = t >= 1 ? prow - NPAD : prow; const bf16_t* prow2 = t >= 2 ? prow - 2 * NPAD : prow;
                    u32x4 rcc[2][3], rcx[2][3], rvb[2], rvg[2];
#pragma unroll
                    for (int j = 0; j < 2; ++j) { const int c = j * 512 + lane * 8;
                        rcc[j][0] = *(const u32x4*)(prow + C_CVC + c); rcx[j][0] = *(const u32x4*)(prow + C_CVX + c);
                        rcc[j][1] = *(const u32x4*)(prow1 + C_CVC + c); rcx[j][1] = *(const u32x4*)(prow1 + C_CVX + c);
                        rcc[j][2] = *(const u32x4*)(prow2 + C_CVC + c); rcx[j][2] = *(const u32x4*)(prow2 + C_CVX + c);
                        rvb[j] = *(const u32x4*)(prow + C_CVB + c); rvg[j] = *(const u32x4*)(prow + C_CVG + c); }
                    const float2 cs = tab[pos * 32 + (lane & 31)];
                    {
                        float f[16]; unpack8(rq0, f); unpack8(rq1, f + 8);
                        float ss = 0.f;
#pragma unroll
                        for (int e = 0; e < 16; ++e) ss += f[e] * f[e];
                        const float rstd = rsqrtf(wave_sum(ss) * (1.f / QL) + NORM_EPS);
#pragma unroll
                        for (int j = 0; j < 2; ++j) { const f32x4 g0 = *(const f32x4*)(gq + j * 512 + lane * 8), g1 = *(const f32x4*)(gq + j * 512 + lane * 8 + 4);
                            float y[8];
#pragma unroll
                            for (int e = 0; e < 4; ++e) { y[e] = f[j * 8 + e] * rstd * g0[e]; y[4 + e] = f[j * 8 + 4 + e] * rstd * g1[e]; }
                            *(u32x4*)(qin + (size_t)m * QL + j * 512 + lane * 8) = pack8(y); }
                    }
                    {
                        float f[8]; unpack8(rkv, f);
                        float ss = 0.f;
#pragma unroll
                        for (int e = 0; e < 8; ++e) ss += f[e] * f[e];
                        const float rstd = rsqrtf(wave_sum(ss) * (1.f / KVL) + NORM_EPS);
                        const f32x4 g0 = *(const f32x4*)(gkv + lane * 8), g1 = *(const f32x4*)(gkv + lane * 8 + 4);
                        float y[8];
#pragma unroll
                        for (int e = 0; e < 4; ++e) { y[e] = f[e] * rstd * g0[e]; y[4 + e] = f[4 + e] * rstd * g1[e]; }
                        *(f32x4*)(lat_out + lane * 8) = (f32x4){y[0], y[1], y[2], y[3]}; *(f32x4*)(lat_out + lane * 8 + 4) = (f32x4){y[4], y[5], y[6], y[7]};
                        *(u32x4*)(latall + lrow * KVL + lane * 8) = pack8(y);
                    }
                    {
                        const float x = bf2f(rkr);
                        const float rstd = rsqrtf(wave_sum(x * x) * (1.f / ROPE) + NORM_EPS);
                        const float y = x * rstd * gkr[lane];
                        const float pt = __shfl_xor(y, 32);
                        const float o = lane < 32 ? y * cs.x - pt * cs.y : y * cs.x + pt * cs.y;
                        kr_out[lane] = o; Krb[lrow * ROPE + lane] = f2bf(o);
                    }
                    {
                        const float* cbuf = args.in[8] + (size_t)(l * DB + b) * 2 * CONVD;
                        float* cv_out = smp ? out + O_CVS + (size_t)(l * DB + b) * 2 * CONVD : out + O_CVP + (size_t)(l * NB + b) * 2 * CONVD;
#pragma unroll
                        for (int j = 0; j < 2; ++j) {
                            const int c = j * 512 + lane * 8;
                            float u0[8], u1[8], u2[8], fa[8], fb[8];
                            unpack8(rcc[j][0], fa); unpack8(rcx[j][0], fb);
#pragma unroll
                            for (int e = 0; e < 8; ++e) u0[e] = fa[e] * fb[e];
                            if (t >= 1) { unpack8(rcc[j][1], fa); unpack8(rcx[j][1], fb);
#pragma unroll
                                for (int e = 0; e < 8; ++e) u1[e] = fa[e] * fb[e]; }
                            else {
#pragma unroll
                                for (int e = 0; e < 8; ++e) u1[e] = smp ? cbuf[CONVD + c + e] : 0.f; }
                            if (t >= 2) { unpack8(rcc[j][2], fa); unpack8(rcx[j][2], fb);
#pragma unroll
                                for (int e = 0; e < 8; ++e) u2[e] = fa[e] * fb[e]; }
                            else {
#pragma unroll
                                for (int e = 0; e < 8; ++e) u2[e] = smp ? cbuf[t * CONVD + c + e] : 0.f; }
                            float vb[8], vg[8], y[8];
                            unpack8(rvb[j], vb); unpack8(rvg[j], vg);
#pragma unroll
                            for (int e = 0; e < 8; ++e) { const float yy = cb[c + e] + u2[e] * cw[c + e] + u1[e] * cw[CONVD + c + e] + u0[e] * cw[2 * CONVD + c + e];
                                y[e] = vb[e] * yy * siluf_(vg[e]); }
                            *(u32x4*)(hmix + (size_t)m * DM + 3072 + c) = pack8(y);
                            if (t >= T - 2) { float* co = cv_out + (size_t)(t - (T - 2)) * CONVD + c;
                                *(f32x4*)co = (f32x4){u0[0], u0[1], u0[2], u0[3]}; *(f32x4*)(co + 4) = (f32x4){u0[4], u0[5], u0[6], u0[7]}; }
                        }
                    }
#pragma unroll
                    for (int j = 0; j < 6; ++j) {
                        const int c = j * 512 + lane * 8;
                        float f[8]; unpack8(rgt[j], f);
#pragma unroll
                        for (int e = 0; e < 8; ++e) f[e] = siluf_(f[e]);
                        *(u32x4*)(hmix + (size_t)m * DM + c) = pack8(f);
                    }
                }
            }
            {
                const float* clat = args.in[4] + (size_t)l * DB * PAST * KVL; const float* ckr = args.in[5] + (size_t)l * DB * PAST * ROPE;
                if (G == 256) {
                    for (int r0 = gw; r0 < DB * PAST; r0 += 4 * 2048) {
                        f32x4 a0[4], a1[4]; float kx[4];
#pragma unroll
                        for (int q = 0; q < 4; ++q) { const int r = r0 + q * 2048;
                            a0[q] = *(const f32x4*)(clat + (size_t)r * KVL + lane * 8); a1[q] = *(const f32x4*)(clat + (size_t)r * KVL + lane * 8 + 4); kx[q] = ckr[(size_t)r * ROPE + lane]; }
#pragma unroll
                        for (int q = 0; q < 4; ++q) { const int r = r0 + q * 2048;
                            const int b = r >> 11, p = r & 2047; const size_t lrow = (size_t)MP + (size_t)b * SKEYS + p;
                            u32x4 w; w.x = cvtpk(a0[q].x, a0[q].y); w.y = cvtpk(a0[q].z, a0[q].w); w.z = cvtpk(a1[q].x, a1[q].y); w.w = cvtpk(a1[q].z, a1[q].w);
                            *(u32x4*)(latall + lrow * KVL + lane * 8) = w;
                            Krb[lrow * ROPE + lane] = f2bf(kx[q]); }
                    }
                } else {
                    for (int r = gw; r < DB * PAST; r += ngw) {
                        const int b = r >> 11, p = r & 2047; const size_t lrow = (size_t)MP + (size_t)b * SKEYS + p;
                        const f32x4 a0 = *(const f32x4*)(clat + (size_t)r * KVL + lane * 8), a1 = *(const f32x4*)(clat + (size_t)r * KVL + lane * 8 + 4);
                        u32x4 w; w.x = cvtpk(a0.x, a0.y); w.y = cvtpk(a0.z, a0.w); w.z = cvtpk(a1.x, a1.y); w.w = cvtpk(a1.z, a1.w);
                        *(u32x4*)(latall + lrow * KVL + lane * 8) = w;
                        Krb[lrow * ROPE + lane] = f2bf(ckr[(size_t)r * ROPE + lane]);
                    }
                }
            }
            for (int i = bx * 512 + tid; i < 20 * SHIFT_DIM; i += G * 512) {
                const int seq = i / SHIFT_DIM, col = i % SHIFT_DIM;
                const int mlast = seq < 4 ? seq * SEQ + SEQ - 1 : MP + (seq - 4) * DS + DS - 1;
                float* dst = seq < 4 ? out + O_SHP + (size_t)(l * NB + seq) * SHIFT_DIM : out + O_SHS + (size_t)(l * DB + (seq - 4)) * SHIFT_DIM;
                dst[col] = bf2f(proj[(size_t)mlast * NPAD + col]);
            }
        }
        SEAM(pb + 2);
        if (IN(pb + 3) && EN(5)) {
            {
                PHASE_LOCALS
                char* chkb = (char*)(ws + WS_CHK);
                LAS char* wl = (LAS char*)lds + wave * 16384;
                constexpr int NIT = NB * 16 * (SEQ / 16) + DB * 16 * (DS / 16), NPR = NB * 16 * (SEQ / 16);
#define REC_OF(it_) ((it_) < NPR ? scanrec + (size_t)(it_) * 16 * REC   : scanrec + ((size_t)SREC_S0 + (size_t)((it_) - NPR) * 16) * REC)
#pragma unroll 1
                for (int it = gw; it < NIT; it += ngw) chk::precompute(REC_OF(it), chkb + (size_t)it * chk::CHKB, wl, lane);
#undef REC_OF
            }
            xcd_barrier(bar);
            {
                PHASE_LOCALS
                const char* chkb = (const char*)(ws + WS_CHK);
                const bool split = (G == 256);
                const bool do_gemm = !split || bx >= 64, do_scan = !split || bx < 64;
                const int GG = split ? 192 : G, gc = split ? bx - 64 : bx;
                if (do_gemm) {
                    if (EN(10)) { pg8::Gemm g{qin, wtuq, M, QW, QL}; pg8::StaticOrder S; S.init(M, QW, GG, gc);
                      pg8::EpiBf16 E{Qb, QW, 0, 0};
                      pg8::gemm_phase<pg8::EpiBf16, pg8::StaticOrder, true, true>(lds, g, S, E); }
                }
                if (EN(11)) {
                    pg8::Gemm g{latall, wtukv, KROWS, 2 * MLAD, KVL};
                    pg8::EpiKV E{Kn, Vb, args.in[30] + (size_t)l * 128, (LAS float*)(lds + XL_OFF)};
                    if (split) { pg8::KvOrder S; S.init(KROWS, 2 * MLAD, bx); pg8::gemm_phase<pg8::EpiKV, pg8::KvOrder, true, true>(lds, g, S, E); }
                    else { pg8::StaticOrder S; S.init(KROWS, 2 * MLAD, G, (bx + G / 2) % G); pg8::gemm_phase<pg8::EpiKV, pg8::StaticOrder, true, true>(lds, g, S, E); }
                }
                __syncthreads();
                if (do_scan && EN(9)) {
                    const int sw = split ? bx : bx, nsw = split ? 64 : G;
#pragma unroll 1
                    for (int bh = sw; bh < NB * 16; bh += nsw) {
                        const int b = bh >> 4, h = bh & 15;
                        chk::seq_wg(chkb + (size_t)bh * (SEQ / 16) * chk::CHKB, SEQ / 16, nullptr, obuf + (size_t)b * SEQ * RW + h * 64,
                                    out + O_RWP + ((size_t)(l * NB + b) * 16 + h) * 4096, (LAS char*)lds, wave, lane);
                    }
#pragma unroll 1
                    for (int bh = sw; bh < DB * 16; bh += nsw) {
                        const int b = bh >> 4, h = bh & 15;
                        chk::seq_wg(chkb + ((size_t)NB * 16 * (SEQ / 16) + (size_t)bh * (DS / 16)) * chk::CHKB, DS / 16, args.in[6] + ((size_t)(l * DB + b) * 16 + h) * 4096,
                                    obuf + ((size_t)MP + (size_t)b * DS) * RW + h * 64, out + O_RWS + ((size_t)(l * DB + b) * 16 + h) * 4096, (LAS char*)lds, wave, lane);
                    }
                    __syncthreads();
                }
            }
        }
        SEAM(pb + 3);
        if (IN(pb + 4) && EN(6)) {
            PHASE_LOCALS
            const float* lng = args.in[21] + (size_t)l * RW; const float* lnb = args.in[22] + (size_t)l * RW;
            const int l16 = lane & 15, g16 = lane >> 4;
            for (int m = gw; m < M; m += ngw) {
                const bool smp = m >= MP;
                const int b = smp ? ((m - MP) >> 5) : (m >> 12), t = smp ? ((m - MP) & 31) : (m & 4095);
                f32x4 ov4[4], lg4[4], lb4[4]; u32x2 vu4[4], gg4[4]; float rk4[4];
#pragma unroll
                for (int p = 0; p < 4; ++p) {
                    const int h = p * 4 + g16, c = h * 64 + l16 * 4;
                    const size_t rec = smp ? (size_t)SREC_S0 + (size_t)(b * 16 + h) * DS + t : (size_t)(b * 16 + h) * SEQ + t;
                    ov4[p] = *(const f32x4*)(obuf + (size_t)m * RW + c); vu4[p] = *(const u32x2*)(scanrec + rec * REC + 1024 + l16 * 8); rk4[p] = rkdot[(size_t)m * 16 + h];
                    lg4[p] = *(const f32x4*)(lng + c); lb4[p] = *(const f32x4*)(lnb + c); gg4[p] = *(const u32x2*)(hmix + (size_t)m * DM + c); }
#pragma unroll
                for (int p = 0; p < 4; ++p) {
                    const int h = p * 4 + g16, c = h * 64 + l16 * 4;
                    const f32x4 ov = ov4[p];
                    const float mu_ = sum16((ov.x + ov.y) + (ov.z + ov.w)) * (1.f / 64);
                    const f32x4 d = ov - mu_;
                    const float var = sum16((d.x * d.x + d.y * d.y) + (d.z * d.z + d.w * d.w)) * (1.f / 64);
                    const float rstd = rsqrtf(var + 64e-5f);
                    const u32x2 vu = vu4[p]; const f32x4 vv = {bflo(vu.x), bfhi(vu.x), bflo(vu.y), bfhi(vu.y)};
                    const float rk = rk4[p];
                    const f32x4 lg = lg4[p], lb = lb4[p];
                    u32x2* gp = (u32x2*)(hmix + (size_t)m * DM + c); const u32x2 gg = gg4[p];
                    const float y0 = (d.x * rstd * lg.x + lb.x + rk * vv.x) * bflo(gg.x), y1 = (d.y * rstd * lg.y + lb.y + rk * vv.y) * bfhi(gg.x);
                    const float y2 = (d.z * rstd * lg.z + lb.z + rk * vv.z) * bflo(gg.y), y3 = (d.w * rstd * lg.w + lb.w + rk * vv.w) * bfhi(gg.y);
                    u32x2 w; w.x = cvtpk(y0, y1); w.y = cvtpk(y2, y3); *gp = w;
                }
            }
        }
        if (ATT_PROBE) { SEAM(pb + 4); }
        if (IN(pb + 5) && EN(7)) {
            PHASE_LOCALS
            const float* gqn = args.in[28] + (size_t)l * 128; const float* gqr = args.in[29] + (size_t)l * ROPE;
            for (int v = bx; v < 256; v += G) {
                const int vv = (G == 256) ? ((v & 7) * 32 + (v >> 3)) : v;
                const int bh = vv >> 2, s = vv & 3, b = bh >> 4, h = bh & 15;
#pragma unroll 1
                for (int i = 0; i < 4; ++i) {
                    const int qb = (i == 0) ? 15 - s : (i == 1) ? s : (i == 2) ? 11 - s : 4 + s;
                    const size_t m0 = (size_t)b * SEQ + (size_t)qb * 256, k0 = (size_t)b * SEQ;
                    att::AUnit u{Qb + m0 * QW + h * 192, Kn + ((size_t)h * KROWS + k0) * 128, Vb + ((size_t)h * KROWS + k0) * 128, Krb + k0 * ROPE, hmix + m0 * DM + RW + h * 128, 4 * qb + 4, 8, 4 * qb, 0, qb * 256, gqn, gqr, tab};
                    att::attn_unit<0>(u, (LAS char*)lds);
                    if (ATT_PROBE) { att::AUnit u2 = u; u2.O = (bf16_t*)(ws + WS_SCAN) + (u.O - hmix); att::attn_unit<(ATT_PROBE == 4 ? 0 : ATT_PROBE)>(u2, (LAS char*)lds); }
                }
                {
                    const int sb = v >> 4, sh = v & 15;
                    const size_t m0 = (size_t)MP + (size_t)sb * DS, k0 = (size_t)MP + (size_t)sb * SKEYS;
                    att::AUnit u{Qb + m0 * QW + sh * 192, Kn + ((size_t)sh * KROWS + k0) * 128, Vb + ((size_t)sh * KROWS + k0) * 128, Krb + k0 * ROPE, hmix + m0 * DM + RW + sh * 128, 33, 1, 32, 1, PAST, gqn, gqr, tab};
                    att::attn_unit<0>(u, (LAS char*)lds);
                }
            }
        }
        SEAM(pb + 5);
        if (IN(pb + 6) && EN(8)) {
            PHASE_LOCALS
            if (G == 256) {
                { pg8::Gemm g{hmix, wtout, MP, DM, DM, 0}; pg8::StaticOrder S; S.init(MP, DM, G, bx);
                  pg8::EpiResGate E{xp, xs, out + O_YP, modf_l + 2 * DM};
                  pg8::gemm_phase<pg8::EpiResGate, pg8::StaticOrder, true, true>(lds, g, S, E); }
                { const int un = bx >> 3, ks = bx & 7;
                  pg8::Gemm g{hmix + ks * 512, wtout + ks * 512, M, DM, 512, DM}; pg8::OneUnit S{MP / 256 + (un >> 4), un & 15};
                  pg8::EpiPart E{(float*)(ws + WS_PART) + (size_t)bx * 65536};
                  pg8::gemm_phase<pg8::EpiPart, pg8::OneUnit, true, true>(lds, g, S, E); }
                if (l + 1 < DEPTH) convert_weights(args, l + 1, lds, gw, ngw, wave, lane, 5, nullptr);
                xcd_barrier(bar);
                {
                    const float* part = (const float*)(ws + WS_PART); const float* gate = modf_l + 2 * DM;
                    f32x4 ra[4], rx[4], rg[4];
#pragma unroll
                    for (int q = 0; q < 4; ++q) { const int idx = q * (G * 512) + bx * 512 + tid, r = idx >> 10, c = (idx & 1023) * 4;
                        const float* pp = part + ((size_t)(((r >> 8) * 16 + (c >> 8)) * 8) * 65536 + (size_t)(r & 255) * 256 + (c & 255));
                        f32x4 a = *(const f32x4*)pp;
#pragma unroll
                        for (int k2 = 1; k2 < 8; ++k2) a += *(const f32x4*)(pp + (size_t)k2 * 65536);
                        ra[q] = a; rx[q] = *(const f32x4*)(xs + (size_t)r * DM + c); rg[q] = *(const f32x4*)(gate + (size_t)(4 + (r >> 5)) * (3 * DM) + c); }
#pragma unroll
                    for (int q = 0; q < 4; ++q) { const int idx = q * (G * 512) + bx * 512 + tid, r = idx >> 10, c = (idx & 1023) * 4;
                        *(f32x4*)(out + O_YS + (size_t)r * DM + c) = rx[q] + rg[q] * ra[q]; }
                }
            } else {
                pg8::Gemm g{hmix, wtout, M, DM, DM, 0}; pg8::StaticOrder S; S.init(M, DM, G, bx);
                pg8::EpiResGate E{xp, xs, out + O_YP, modf_l + 2 * DM};
                pg8::gemm_phase<pg8::EpiResGate, pg8::StaticOrder, true, true>(lds, g, S, E);
                if (l + 1 < DEPTH) convert_weights(args, l + 1, lds, gw, ngw, wave, lane, 5, (unsigned*)(ws + WS_CTL) + CW_TICKET + 64 * l);
            }
        }
        SEAM(pb + 6);
    }
#undef IN
#undef SEAM
}

extern "C" void kernel_launch(void* const* d_in, const int* in_sizes, int n_in, void* d_out, int out_size, void* d_ws, size_t ws_size, hipStream_t stream) {
    static int grid = 0;
    if (grid == 0) {
        if (n_in != 35 || (size_t)out_size != O_END || ws_size < WS_END) { fprintf(stderr, "kernel_launch: shape mismatch (n_in %d, out %d, ws %zu)\n", n_in, out_size, ws_size); grid = -1; return; }
        int dev = 0, cus = 0, per_cu = 0;
        if (hipGetDevice(&dev) != hipSuccess || hipDeviceGetAttribute(&cus, hipDeviceAttributeMultiprocessorCount, dev) != hipSuccess) { grid = -1; return; }
        if (hipFuncSetAttribute((const void*)mk_fwd, hipFuncAttributeMaxDynamicSharedMemorySize, LDS_BYTES) != hipSuccess) { fprintf(stderr, "kernel_launch: hipFuncSetAttribute failed\n"); grid = -1; return; }
        if (hipOccupancyMaxActiveBlocksPerMultiprocessor(&per_cu, (const void*)mk_fwd, NWAVES * 64, LDS_BYTES) != hipSuccess || per_cu < 1) { fprintf(stderr, "kernel_launch: occupancy query reports %d\n", per_cu); }
        (void)hipGetLastError();
        grid = cus;
    }
    if (grid < 0) return;
    if (hipMemsetAsync((char*)d_ws + WS_CTL, 0, CTL_ZERO_BYTES, stream) != hipSuccess) return;
    Args a{};
    for (int i = 0; i < 35; ++i) a.in[i] = (const float*)d_in[i];
    a.out = (float*)d_out; a.ws = (unsigned char*)d_ws;
    constexpr int NL = MK_N_LAUNCHES;
    for (int li = 0; li < NL; ++li) {
        a.ph_lo = (NL == 1) ? 0 : li; a.ph_hi = (NL == 1) ? NPHASE : li + 1; a.li = li; a.pad = 0;
        hipLaunchKernelGGL(mk_fwd, dim3(grid), dim3(NWAVES * 64), LDS_BYTES, stream, a);
        const hipError_t le = hipPeekAtLastError();
        if (le != hipSuccess) { fprintf(stderr, "kernel_launch: launch %d failed: %s\n", li, hipGetErrorName(le)); break; }
    }
}
```
